# Optimizing an MI355X kernel written in HIP

```python
import jax, jax.numpy as jnp
from jax import lax
import numpy as np

D_MODEL = 2048
BATCH = 4
SEQ = 4096
DEPTH = 2

N_HEADS = D_MODEL // 128
HEAD_DIM = 64
N_KV_HEADS = N_HEADS // 4
GQA_GROUP = N_HEADS // N_KV_HEADS
D_ATTN = N_HEADS * HEAD_DIM
D_KV = N_KV_HEADS * HEAD_DIM
WINDOW = 128
BLOCK = 128
D_CONV = D_MODEL // 2
CONV_WIDTH = 3
D_FF = ((8 * D_MODEL // 3 + 255) // 256) * 256
N_EXPERTS = 8
TOP_K = 2
MOE_D_FF = 7 * D_MODEL // 2
N_DENSE = (DEPTH + 1) // 2
N_MOE = DEPTH // 2
N_MOD = 6
EPS = 1e-6

IN_WIDTHS = [D_ATTN, D_KV, D_KV, D_CONV, D_CONV, D_CONV, D_MODEL, D_MODEL]
IN_SPLITS = [int(s) for s in np.cumsum(IN_WIDTHS)[:-1]]
D_IN = int(sum(IN_WIDTHS))

kernel_name = "hybrid_swa_shortconv_moe_adaln"


def rms_norm(x, gain):
    xf = x.astype(jnp.float32)
    y = xf * lax.rsqrt(jnp.mean(xf * xf, axis=-1, keepdims=True) + EPS)
    return (y * gain.astype(jnp.float32)).astype(x.dtype)


def alibi_slopes(n_heads):
    return 2.0 ** (-8.0 * jnp.arange(1, n_heads + 1, dtype=jnp.float32) / n_heads)


def sliding_window_attention(q, k, v, sinks):
    b, s = q.shape[0], q.shape[1]
    nb = s // BLOCK
    qb = q.reshape(b, nb, BLOCK, N_KV_HEADS, GQA_GROUP, HEAD_DIM)

    def band(t):
        tb = t.reshape(b, nb, BLOCK, N_KV_HEADS, HEAD_DIM)
        prev = jnp.pad(tb[:, :-1], ((0, 0), (1, 0), (0, 0), (0, 0), (0, 0)))
        return jnp.concatenate([prev, tb], axis=2)

    kw, vw = band(k), band(v)
    scores = jnp.einsum('bnqkgd,bnskd->bnkgqs', qb, kw,
                        preferred_element_type=jnp.float32) * (HEAD_DIM ** -0.5)
    q_rel = jnp.arange(BLOCK) + BLOCK
    k_rel = jnp.arange(2 * BLOCK)
    dist = q_rel[:, None] - k_rel[None, :]
    key_abs = (jnp.arange(nb) * BLOCK - BLOCK)[:, None] + k_rel[None, :]
    valid = ((dist >= 0) & (dist < WINDOW))[None] & (key_abs >= 0)[:, None, :]
    slopes = alibi_slopes(N_HEADS).reshape(N_KV_HEADS, GQA_GROUP)
    logits = scores - slopes[:, :, None, None] * dist.astype(jnp.float32)
    logits = jnp.where(valid[None, :, None, None], logits, -jnp.inf)
    sink = jnp.broadcast_to(sinks.astype(jnp.float32).reshape(N_KV_HEADS, GQA_GROUP, 1, 1),
                            logits.shape[:-1] + (1,))
    probs = jax.nn.softmax(jnp.concatenate([logits, sink], axis=-1), axis=-1)[..., :-1]
    out = jnp.einsum('bnkgqs,bnskd->bnqkgd', probs.astype(v.dtype), vw)
    return out.reshape(b, s, D_ATTN)


def short_conv(u, w):
    return lax.conv_general_dilated(u, w[:, None, :], window_strides=(1,),
                                    padding=[(CONV_WIDTH - 1, 0)],
                                    dimension_numbers=('NWC', 'WIO', 'NWC'),
                                    feature_group_count=D_CONV)


def swiglu(h, w_gate_up, w_down):
    g, u = jnp.split(h @ w_gate_up, 2, axis=-1)
    return (jax.nn.silu(g) * u) @ w_down


def moe_swiglu(h, w_router, w_gate_up, w_down):
    t = h.reshape(-1, D_MODEL)
    logits = (t @ w_router).astype(jnp.float32)
    top_v, top_i = lax.top_k(logits, TOP_K)
    top_w = jax.nn.softmax(top_v, axis=-1)
    gates = jnp.sum(jax.nn.one_hot(top_i, N_EXPERTS, dtype=jnp.float32) * top_w[..., None], axis=1)
    out = jnp.zeros_like(t)
    for e in range(N_EXPERTS):
        out = out + gates[:, e:e + 1].astype(t.dtype) * swiglu(t, w_gate_up[e], w_down[e])
    return out.reshape(h.shape)


def setup_inputs(seed: int = 0) -> dict:
    key = jax.random.key(seed)
    ks = jax.random.split(key, 20)

    def nrm(k, shape, scale):
        return jax.random.normal(k, shape, jnp.float32) * scale

    return {
        "x": nrm(ks[0], (BATCH, SEQ, D_MODEL), 1.0),
        "c": nrm(ks[1], (BATCH, D_MODEL), 1.0),
        "ada_w": nrm(ks[2], (DEPTH, D_MODEL, N_MOD * D_MODEL), 0.5 * D_MODEL ** -0.5),
        "ada_b": nrm(ks[3], (DEPTH, N_MOD * D_MODEL), 0.02),
        "norm_mix": 1.0 + nrm(ks[4], (DEPTH, D_MODEL), 0.05),
        "w_in": nrm(ks[5], (DEPTH, D_MODEL, D_IN), D_MODEL ** -0.5),
        "q_norm": 1.0 + nrm(ks[6], (DEPTH, HEAD_DIM), 0.05),
        "k_norm": 1.0 + nrm(ks[7], (DEPTH, HEAD_DIM), 0.05),
        "attn_sinks": nrm(ks[8], (DEPTH, N_HEADS), 0.5),
        "conv_w": nrm(ks[9], (DEPTH, CONV_WIDTH, D_CONV), CONV_WIDTH ** -0.5),
        "w_attn_branch": nrm(ks[10], (DEPTH, D_ATTN, D_MODEL), D_ATTN ** -0.5),
        "w_conv_branch": nrm(ks[11], (DEPTH, D_CONV, D_MODEL), D_CONV ** -0.5),
        "w_out": nrm(ks[12], (DEPTH, D_MODEL, D_MODEL), D_MODEL ** -0.5),
        "norm_ffn": 1.0 + nrm(ks[13], (DEPTH, D_MODEL), 0.05),
        "ffn_w_gate_up": nrm(ks[14], (N_DENSE, D_MODEL, 2 * D_FF), D_MODEL ** -0.5),
        "ffn_w_down": nrm(ks[15], (N_DENSE, D_FF, D_MODEL), D_FF ** -0.5),
        "moe_w_router": nrm(ks[16], (N_MOE, D_MODEL, N_EXPERTS), D_MODEL ** -0.5),
        "moe_w_gate_up": nrm(ks[17], (N_MOE, N_EXPERTS, D_MODEL, 2 * MOE_D_FF), D_MODEL ** -0.5),
        "moe_w_down": nrm(ks[18], (N_MOE, N_EXPERTS, MOE_D_FF, D_MODEL), MOE_D_FF ** -0.5),
    }


def reference(x, c, ada_w, ada_b, norm_mix, w_in, q_norm, k_norm, attn_sinks, conv_w,
              w_attn_branch, w_conv_branch, w_out, norm_ffn, ffn_w_gate_up, ffn_w_down,
              moe_w_router, moe_w_gate_up, moe_w_down):
    b, s = x.shape[0], x.shape[1]
    for l in range(DEPTH):
        mod = jax.nn.silu(c) @ ada_w[l] + ada_b[l]
        shift_m, scale_m, gate_m, shift_f, scale_f, gate_f = jnp.split(mod[:, None, :], N_MOD, axis=-1)

        h = rms_norm(x, norm_mix[l]) * (1.0 + scale_m) + shift_m
        q, k, v, conv_b, conv_c, conv_x, g_attn, g_conv = jnp.split(h @ w_in[l], IN_SPLITS, axis=-1)
        q = rms_norm(q.reshape(b, s, N_HEADS, HEAD_DIM), q_norm[l])
        k = rms_norm(k.reshape(b, s, N_KV_HEADS, HEAD_DIM), k_norm[l])
        v = v.reshape(b, s, N_KV_HEADS, HEAD_DIM)
        attn = sliding_window_attention(q, k, v, attn_sinks[l])
        conv = conv_b * short_conv(conv_c * conv_x, conv_w[l])
        merged = (jax.nn.sigmoid(g_attn) * (attn @ w_attn_branch[l])
                  + jax.nn.sigmoid(g_conv) * (conv @ w_conv_branch[l]))
        x = x + gate_m * (merged @ w_out[l])

        h = rms_norm(x, norm_ffn[l]) * (1.0 + scale_f) + shift_f
        if l % 2 == 0:
            f = swiglu(h, ffn_w_gate_up[l // 2], ffn_w_down[l // 2])
        else:
            f = moe_swiglu(h, moe_w_router[l // 2], moe_w_gate_up[l // 2], moe_w_down[l // 2])
        x = x + gate_f * f
    return x
```

```cpp
#include <hip/hip_runtime.h>
#include <cstdio>
#include <cstdint>

#ifndef MK_PROBE_MASK
#define MK_PROBE_MASK 0
#endif
#ifndef MK_N_LAUNCHES
#define MK_N_LAUNCHES 1
#endif

constexpr int T = 16384, SEQ = 4096, NBATCH = 4, D = 2048, DIN = 8704, DATT = 1024, DKV = 256, DCONV = 1024, DFF = 5632, MFF = 7168, NEXP = 8;
constexpr int MODW = 6 * D;
constexpr int NSLOT = 2 * T + NEXP * 256;
constexpr float EPS = 1e-6f;
constexpr float LOG2E = 1.4426950408889634f;
constexpr float ACT8_SCALE = 4.0f;
constexpr int MDN8_LOG2 = 7;
constexpr float W8I_SCALE = 1448.0f;
constexpr float QSCALE = 0.125f * LOG2E;

constexpr size_t MiB = (size_t)1 << 20;
constexpr size_t WS_CTL = 0, CTL_ZERO_BYTES = 1 * MiB;
constexpr size_t WS_MOD = 1 * MiB;
constexpr size_t WS_MOE = 2 * MiB;
constexpr size_t WS_WIN = 4 * MiB;
constexpr size_t WS_WAC = 72 * MiB;
constexpr size_t WS_WOUT = 88 * MiB;
constexpr size_t WS_WGU = 104 * MiB;
constexpr size_t WS_WDN = 148 * MiB;
constexpr size_t WS_MGU = 170 * MiB;
constexpr size_t WS_MDN = 618 * MiB;
constexpr size_t WS_H = 842 * MiB;
constexpr size_t WS_Q = 906 * MiB;
constexpr size_t WS_K = 938 * MiB;
constexpr size_t WS_V = 946 * MiB;
constexpr size_t WS_BC = 954 * MiB;
constexpr size_t WS_U = 986 * MiB;
constexpr size_t WS_R = 1018 * MiB;
constexpr size_t WS_GC = 1082 * MiB;
constexpr size_t WS_AC = 1146 * MiB;
constexpr size_t WS_MG = 1210 * MiB;
constexpr size_t WS_X1 = 1274 * MiB;
constexpr size_t WS_X2 = 1402 * MiB;
constexpr size_t WS_ACT = 1530 * MiB;
constexpr size_t WS_XG = 2006 * MiB;
constexpr size_t WS_Y = 2142 * MiB;
constexpr size_t WS_END = 2414 * MiB;
constexpr int CW_BAR = 4096;

constexpr int RING_BYTES = 131072;
constexpr int LDSCTL_OFF = RING_BYTES, MISC_OFF = LDSCTL_OFF + 320;
constexpr int LDS_BYTES = 147456;

#define GAS __attribute__((address_space(1)))
#define LAS __attribute__((address_space(3)))
typedef unsigned v4u __attribute__((ext_vector_type(4)));
typedef unsigned v2u __attribute__((ext_vector_type(2)));
typedef short s16x4 __attribute__((ext_vector_type(4)));
#define LDS_WAIT() asm volatile("s_waitcnt lgkmcnt(0)" ::: "memory")
#define VM_WAIT() asm volatile("s_waitcnt vmcnt(0)" ::: "memory")

namespace pg8 {
#define PG8_LAS __attribute__((address_space(3)))
typedef unsigned short bf16_t;
typedef short bf16x8 __attribute__((ext_vector_type(8)));
typedef float f32x4 __attribute__((ext_vector_type(4)));
typedef unsigned u32x4 __attribute__((ext_vector_type(4)));
constexpr int BM = 256, BK = 64, HALF = 128, HTB = HALF * BK * 2  , STAGE_BYTES = 8 * HTB, NXCD = 8, WGM = 4;

__host__ __device__ __forceinline__ int lds_byte(int r, int c) { const int st = (r >> 4) * 2 + (c >> 5), rr = r & 15, cc = c & 31, ob = rr * 64 + cc * 2; return st * 1024 + (ob ^ (((ob >> 9) & 1) << 5)); }
__host__ __device__ __forceinline__ void stage_rc(int b, int& R, int& C) { const int st = b / 1024, sb = b % 1024, swz = sb ^ (((sb >> 9) & 1) << 5); R = (st >> 1) * 16 + swz / 64; C = (st & 1) * 32 + (swz % 64) / 2; }
__host__ __device__ __forceinline__ int perm32(int rho) { const int n = rho >> 4, i = rho & 15; return 8 * (i >> 2) + 4 * n + (i & 3); }

struct Unit { int pm, pn; };
struct Gemm { const bf16_t* A; const bf16_t* Bt; int M, N, K; int sB = 0x7f7f; int Kloop = 0; };
typedef int v8i __attribute__((ext_vector_type(8)));
typedef int v4i __attribute__((ext_vector_type(4)));

struct StaticOrder {
    int nM, nN, nwg, G, c;
    __host__ __device__ void init(int M, int N, int G_, int c_) { nM = M / BM; nN = N / BM; nwg = nM * nN; G = G_; c = c_; }
    __host__ __device__ bool next(int i, Unit& u) const {
        const long L = (long)i * G + c; if (L >= nwg) return false;
        int wgid = (int)L; { const int q = nwg / NXCD, r = nwg % NXCD, xcd = wgid % NXCD, off = wgid / NXCD; wgid = (xcd < r ? xcd * (q + 1) : r * (q + 1) + (xcd - r) * q) + off; }
        const int nig = WGM * nN, gid = wgid / nig, fm = gid * WGM, gsz = (nM - fm) < WGM ? (nM - fm) : WGM;
        u.pm = fm + ((wgid % nig) % gsz); u.pn = (wgid % nig) / gsz; return true;
    }
    __device__ __forceinline__ void a_ready(const Unit&) const {}
    __device__ __forceinline__ void done(const Unit&) const {}
};

__device__ __forceinline__ unsigned cvt_pk_bf16(float lo, float hi) { unsigned r; asm volatile("v_cvt_pk_bf16_f32 %0, %1, %2" : "=v"(r) : "v"(lo), "v"(hi)); return r; }
__device__ __forceinline__ u32x4 pack8(const f32x4 a, const f32x4 b) { u32x4 w; w.x = cvt_pk_bf16(a[0], a[1]); w.y = cvt_pk_bf16(a[2], a[3]); w.z = cvt_pk_bf16(b[0], b[1]); w.w = cvt_pk_bf16(b[2], b[3]); return w; }
__device__ __forceinline__ void unpack8(const u32x4 w, f32x4& a, f32x4& b) {
    a[0] = __uint_as_float(w.x << 16); a[1] = __uint_as_float(w.x & 0xffff0000u); a[2] = __uint_as_float(w.y << 16); a[3] = __uint_as_float(w.y & 0xffff0000u);
    b[0] = __uint_as_float(w.z << 16); b[1] = __uint_as_float(w.z & 0xffff0000u); b[2] = __uint_as_float(w.w << 16); b[3] = __uint_as_float(w.w & 0xffff0000u); }
__device__ __forceinline__ float fast_exp(float x) { return __builtin_amdgcn_exp2f(x * 1.4426950408889634f); }
__device__ __forceinline__ float sigmoid_f(float x) { return __builtin_amdgcn_rcpf(1.0f + fast_exp(-x)); }
__device__ __forceinline__ unsigned pk4_i8(float a, float b, float c, float d) {
    const int ia = (int)__builtin_rintf(__builtin_amdgcn_fmed3f(a, -127.0f, 127.0f)), ib = (int)__builtin_rintf(__builtin_amdgcn_fmed3f(b, -127.0f, 127.0f)),
              ic = (int)__builtin_rintf(__builtin_amdgcn_fmed3f(c, -127.0f, 127.0f)), id = (int)__builtin_rintf(__builtin_amdgcn_fmed3f(d, -127.0f, 127.0f));
    return ((unsigned)ia & 0xffu) | (((unsigned)ib & 0xffu) << 8) | (((unsigned)ic & 0xffu) << 16) | ((unsigned)id << 24); }
__device__ __forceinline__ void acc_i32_to_f32(f32x4 (&acc)[2][2][4][2], const float* rowscale, size_t row0, float wsc) {
#pragma unroll
    for (int ai = 0; ai < 2; ++ai)
#pragma unroll
        for (int m = 0; m < 4; ++m) { const float rs = rowscale[row0 + ai * HALF + m * 16] * wsc;
#pragma unroll
            for (int bj = 0; bj < 2; ++bj)
#pragma unroll
                for (int n = 0; n < 2; ++n) { const v4i iv = __builtin_bit_cast(v4i, acc[ai][bj][m][n]); acc[ai][bj][m][n] = (f32x4){(float)iv[0] * rs, (float)iv[1] * rs, (float)iv[2] * rs, (float)iv[3] * rs}; } }
}
__device__ __forceinline__ unsigned pk4_fp8(float a, float b, float c, float d) {
    a = __builtin_amdgcn_fmed3f(a, -448.0f, 448.0f); b = __builtin_amdgcn_fmed3f(b, -448.0f, 448.0f); c = __builtin_amdgcn_fmed3f(c, -448.0f, 448.0f); d = __builtin_amdgcn_fmed3f(d, -448.0f, 448.0f);
    int w = 0; w = __builtin_amdgcn_cvt_pk_fp8_f32(a, b, w, false); w = __builtin_amdgcn_cvt_pk_fp8_f32(c, d, w, true); return (unsigned)w; }

struct MergeOrder {
    StaticOrder so;
    __device__ void init(int G_, int c_) { so.init(16384, 2048, G_, c_); }
    __device__ bool next(int i, Unit& u) const { if (!so.next(i >> 1, u)) return false; if (i & 1) { u.pm += 64; u.pn += 8; } return true; }
    __device__ __forceinline__ void a_ready(const Unit&) const {}
    __device__ __forceinline__ void done(const Unit&) const {}
};
struct GroupedOrder {
    int NT, G, c, total; PG8_LAS int* tab;
    __device__ __forceinline__ void decode(int i, int& pm, int& pn) const {
        const int L = i * G + c; if (L >= total) { pm = -1; pn = 0; return; }
        int wgid = L; { const int q = total / NXCD, r = total % NXCD, xcd = wgid % NXCD, off = wgid / NXCD; wgid = (xcd < r ? xcd * (q + 1) : r * (q + 1) + (xcd - r) * q) + off; }
        int e = 0;
#pragma unroll
        for (int j = 1; j < 8; ++j) e += (wgid >= tab[j]) ? 1 : 0;
        const int base = tab[e], nM = tab[16 + e], r0 = tab[32 + e];
        const int idx = wgid - base, nig = WGM * NT, gid = idx / nig, fm = gid * WGM, gsz = (nM - fm) < WGM ? (nM - fm) : WGM, rem = idx % nig;
        pm = r0 + fm + rem % gsz; pn = e * NT + rem / gsz;
    }
    __device__ __forceinline__ void init(PG8_LAS int* tab_, const int* GT, int NT_, int G_, int c_) {
        NT = NT_; G = G_; c = c_; tab = tab_;
        __syncthreads();
        if (threadIdx.x == 0) { int up = 0; for (int e = 0; e < 8; ++e) { const int r = GT[e], n = GT[8 + e]; tab[e] = up; tab[16 + e] = n; tab[32 + e] = r; up += n * NT_; } tab[8] = up; }
        __syncthreads();
        total = __builtin_amdgcn_readfirstlane(tab[8]);
        if (threadIdx.x < 64) { int pm, pn; decode((int)threadIdx.x, pm, pn); tab[64 + 2 * threadIdx.x] = pm; tab[65 + 2 * threadIdx.x] = pn; }
        __syncthreads();
    }
    __device__ __forceinline__ bool next(int i, Unit& u) const {
        if (i >= 64) return false;
        const int pm = __builtin_amdgcn_readfirstlane(tab[64 + 2 * i]); if (pm < 0) return false;
        u.pm = pm; u.pn = __builtin_amdgcn_readfirstlane(tab[65 + 2 * i]); return true;
    }
    __device__ __forceinline__ void a_ready(const Unit&) const {}
    __device__ __forceinline__ void done(const Unit&) const {}
};

struct DownMainOrder {
    StaticOrder so; PG8_LAS int* tab;
    __device__ __forceinline__ void init(PG8_LAS int* tab_, int G_, int c_) { so.init(128 * BM, 8 * BM, G_, c_); tab = tab_; }
    __device__ __forceinline__ bool next(int i, Unit& u) const {
        if (!so.next(i, u)) return false;
        int e = 0;
#pragma unroll
        for (int j = 1; j < 8; ++j) e += (u.pm >= __builtin_amdgcn_readfirstlane(tab[32 + j])) ? 1 : 0;
        u.pn += e * 8; return true;
    }
    __device__ __forceinline__ void a_ready(const Unit&) const {}
    __device__ __forceinline__ void done(const Unit&) const {}
};
struct DownSpillOrder {
    int c, nunits; PG8_LAS int* tab;
    __device__ __forceinline__ void init(PG8_LAS int* tab_, int c_, int ntiles) { c = c_; nunits = (ntiles - 128) * 32; tab = tab_; }
    __device__ __forceinline__ bool next(int i, Unit& u) const {
        if (i != 0 || c >= nunits) return false;
        u.pm = 128 + (c >> 5); int e = 0;
#pragma unroll
        for (int j = 1; j < 8; ++j) e += (u.pm >= __builtin_amdgcn_readfirstlane(tab[32 + j])) ? 1 : 0;
        u.pn = e * 8 + ((c >> 2) & 7); return true;
    }
    __device__ __forceinline__ void a_ready(const Unit&) const {}
    __device__ __forceinline__ void done(const Unit&) const {}
};

struct EpiWin {
    static constexpr bool PERM = true, AFTER_DRAIN = false;
    bf16_t *Q, *K, *V, *BC, *U, *R, *GC; const float *qn, *kn; const float* rowscale; float wsc;
    __device__ __forceinline__ bool zero_after(const Unit&) const { return true; }
    __device__ __forceinline__ void operator()(f32x4 (&acc)[2][2][4][2], const Unit& u, int wr, int wc, int fr, int fq) const {
        const int pn = u.pn; const size_t row0 = (size_t)u.pm * BM + wr * 64 + fr;
        acc_i32_to_f32(acc, rowscale, row0, wsc);
        if (pn < 5) {
            const bool isq = pn < 4; const float* gn = isq ? qn : kn; const float osc = isq ? QSCALE : 1.0f;
            bf16_t* dst = isq ? Q : K; const int ld = isq ? DATT : DKV; const int hcol = (isq ? pn * 4 + wc : wc) * 64 + 8 * fq;
            f32x4 g[2][2];
#pragma unroll
            for (int bj = 0; bj < 2; ++bj)
#pragma unroll
                for (int n = 0; n < 2; ++n) g[bj][n] = *(const f32x4*)(gn + 32 * bj + 8 * fq + 4 * n) * osc;
#pragma unroll
            for (int ai = 0; ai < 2; ++ai)
#pragma unroll
                for (int m = 0; m < 4; ++m) {
                    float ss = 0.f;
#pragma unroll
                    for (int bj = 0; bj < 2; ++bj)
#pragma unroll
                        for (int n = 0; n < 2; ++n) { const f32x4 x = acc[ai][bj][m][n]; ss += (x[0] * x[0] + x[1] * x[1]) + (x[2] * x[2] + x[3] * x[3]); }
                    ss += __shfl_xor(ss, 16); ss += __shfl_xor(ss, 32);
                    const float rinv = 1.0f / sqrtf(ss * (1.0f / 64.0f) + EPS);
                    bf16_t* rowp = dst + (row0 + ai * HALF + m * 16) * ld + hcol;
#pragma unroll
                    for (int bj = 0; bj < 2; ++bj) *(u32x4*)(rowp + 32 * bj) = pack8(acc[ai][bj][m][0] * rinv * g[bj][0], acc[ai][bj][m][1] * rinv * g[bj][1]);
                }
        } else if (pn < 10) {
            const bool isv = pn == 5; bf16_t* dst = isv ? V : BC; const int ld = isv ? DKV : DCONV; const int col0 = (isv ? 0 : (pn - 6) * BM) + wc * 32 + 8 * fq;
#pragma unroll
            for (int ai = 0; ai < 2; ++ai)
#pragma unroll
                for (int m = 0; m < 4; ++m) { bf16_t* rowp = dst + (row0 + ai * HALF + m * 16) * ld + col0;
#pragma unroll
                    for (int bj = 0; bj < 2; ++bj) *(u32x4*)(rowp + bj * HALF) = pack8(acc[ai][bj][m][0], acc[ai][bj][m][1]); }
        } else if (pn < 18) {
            const int col0 = (pn - 10) * HALF + wc * 32 + 8 * fq;
#pragma unroll
            for (int ai = 0; ai < 2; ++ai)
#pragma unroll
                for (int m = 0; m < 4; ++m) *(u32x4*)(U + (row0 + ai * HALF + m * 16) * DCONV + col0) = pack8(acc[ai][0][m][0] * acc[ai][1][m][0], acc[ai][0][m][1] * acc[ai][1][m][1]);
        } else {
            const int col0 = (pn - 18) * HALF + wc * 32 + 8 * fq;
#pragma unroll
            for (int ai = 0; ai < 2; ++ai)
#pragma unroll
                for (int m = 0; m < 4; ++m) { f32x4 rr[2], sc[2];
#pragma unroll
                    for (int n = 0; n < 2; ++n)
#pragma unroll
                        for (int j = 0; j < 4; ++j) { const float ea = 1.0f + fast_exp(-acc[ai][0][m][n][j]); const float ec = 1.0f + fast_exp(-fmaxf(acc[ai][1][m][n][j], -30.0f));
                            const float ia = __builtin_amdgcn_rcpf(ea); rr[n][j] = ec * ia; sc[n][j] = __builtin_amdgcn_rcpf(ec); }
                    const size_t off = (row0 + ai * HALF + m * 16) * D + col0;
                    *(u32x4*)(R + off) = pack8(rr[0], rr[1]); *(u32x4*)(GC + off) = pack8(sc[0], sc[1]); }
        }
    }
};
struct EpiMerge {
    static constexpr bool PERM = true, AFTER_DRAIN = false;
    const bf16_t *R, *GC; bf16_t* MG;
    __device__ __forceinline__ bool zero_after(const Unit& u) const { return u.pm >= 64; }
    __device__ __forceinline__ void operator()(f32x4 (&acc)[2][2][4][2], const Unit& u, int wr, int wc, int fr, int fq) const {
        const bool second = u.pm >= 64; const int pm = u.pm & 63, pn = u.pn & 7;
        const size_t row0 = (size_t)pm * BM + wr * 64 + fr; const int col0 = pn * BM + wc * 32 + 8 * fq;
        const bf16_t* src = second ? GC : R;
#pragma unroll
        for (int ai = 0; ai < 2; ++ai)
#pragma unroll
            for (int m = 0; m < 4; ++m) { const size_t off = (row0 + ai * HALF + m * 16) * D + col0;
#pragma unroll
                for (int bj = 0; bj < 2; ++bj) { f32x4 a, b; unpack8(*(const u32x4*)(src + off + bj * HALF), a, b);
                    acc[ai][bj][m][0] *= a; acc[ai][bj][m][1] *= b;
                    if (second) *(u32x4*)(MG + off + bj * HALF) = pack8(acc[ai][bj][m][0], acc[ai][bj][m][1]); } }
    }
};
template <bool BASE_BF16>
struct EpiResid {
    static constexpr bool PERM = true, AFTER_DRAIN = false;
    const void* base; bf16_t* out; const float* gate;
    __device__ __forceinline__ bool zero_after(const Unit&) const { return true; }
    __device__ __forceinline__ void operator()(f32x4 (&acc)[2][2][4][2], const Unit& u, int wr, int wc, int fr, int fq) const {
        const size_t row0 = (size_t)u.pm * BM + wr * 64 + fr; const int col0 = u.pn * BM + wc * 32 + 8 * fq;
        const float* gp = gate + (size_t)(u.pm >> 4) * MODW + col0;
        f32x4 gv[2][2];
#pragma unroll
        for (int bj = 0; bj < 2; ++bj)
#pragma unroll
            for (int n = 0; n < 2; ++n) gv[bj][n] = *(const f32x4*)(gp + bj * HALF + n * 4);
#pragma unroll
        for (int ai = 0; ai < 2; ++ai)
#pragma unroll
            for (int m = 0; m < 4; ++m) { const size_t off = (row0 + ai * HALF + m * 16) * D + col0;
#pragma unroll
                for (int bj = 0; bj < 2; ++bj) { f32x4 b0, b1;
                    if (BASE_BF16) unpack8(*(const u32x4*)((const bf16_t*)base + off + bj * HALF), b0, b1);
                    else { b0 = *(const f32x4*)((const float*)base + off + bj * HALF); b1 = *(const f32x4*)((const float*)base + off + bj * HALF + 4); }
                    *(u32x4*)(out + off + bj * HALF) = pack8(b0 + gv[bj][0] * acc[ai][bj][m][0], b1 + gv[bj][1] * acc[ai][bj][m][1]); }
                if (m & 1) asm volatile("" ::: "memory"); }
    }
};
struct EpiSwiglu {
    static constexpr bool PERM = true, AFTER_DRAIN = false;
    bf16_t* O; int ld, NT;
    __device__ __forceinline__ bool zero_after(const Unit&) const { return true; }
    __device__ __forceinline__ void operator()(f32x4 (&acc)[2][2][4][2], const Unit& u, int wr, int wc, int fr, int fq) const {
        const size_t row0 = (size_t)u.pm * BM + wr * 64 + fr; const int col0 = (u.pn % NT) * HALF + wc * 32 + 8 * fq;
#pragma unroll
        for (int ai = 0; ai < 2; ++ai)
#pragma unroll
            for (int m = 0; m < 4; ++m) { f32x4 o[2];
#pragma unroll
                for (int n = 0; n < 2; ++n)
#pragma unroll
                    for (int j = 0; j < 4; ++j) { const float g = acc[ai][0][m][n][j]; o[n][j] = g * sigmoid_f(g) * acc[ai][1][m][n][j]; }
                *(u32x4*)(O + (row0 + ai * HALF + m * 16) * ld + col0) = pack8(o[0], o[1]); }
    }
};
struct EpiSwiglu8 {
    static constexpr bool PERM = true, AFTER_DRAIN = false;
    unsigned char* O; int ld, NT; const float* rowscale; float wsc;
    __device__ __forceinline__ bool zero_after(const Unit&) const { return true; }
    __device__ __forceinline__ void operator()(f32x4 (&acc)[2][2][4][2], const Unit& u, int wr, int wc, int fr, int fq) const {
        const size_t row0 = (size_t)u.pm * BM + wr * 64 + fr; const int col0 = (u.pn % NT) * HALF + wc * 32 + 8 * fq;
        acc_i32_to_f32(acc, rowscale, row0, wsc);
#pragma unroll
        for (int ai = 0; ai < 2; ++ai)
#pragma unroll
            for (int m = 0; m < 4; ++m) { f32x4 o[2];
#pragma unroll
                for (int n = 0; n < 2; ++n)
#pragma unroll
                    for (int j = 0; j < 4; ++j) { const float g = acc[ai][0][m][n][j]; o[n][j] = g * sigmoid_f(g) * acc[ai][1][m][n][j] * ACT8_SCALE; }
                typedef unsigned u32x2 __attribute__((ext_vector_type(2)));
                u32x2 w; w.x = pk4_fp8(o[0][0], o[0][1], o[0][2], o[0][3]); w.y = pk4_fp8(o[1][0], o[1][1], o[1][2], o[1][3]);
                *(u32x2*)(O + (row0 + ai * HALF + m * 16) * ld + col0) = w; }
    }
};
struct EpiY {
    static constexpr bool PERM = true, AFTER_DRAIN = false;
    bf16_t* Y; int pm0;
    __device__ __forceinline__ bool zero_after(const Unit&) const { return true; }
    __device__ __forceinline__ void operator()(f32x4 (&acc)[2][2][4][2], const Unit& u, int wr, int wc, int fr, int fq) const {
        const size_t row0 = (size_t)(u.pm - pm0) * BM + wr * 64 + fr; const int col0 = (u.pn & 7) * BM + wc * 32 + 8 * fq;
#pragma unroll
        for (int ai = 0; ai < 2; ++ai)
#pragma unroll
            for (int m = 0; m < 4; ++m) { bf16_t* rowp = Y + (row0 + ai * HALF + m * 16) * D + col0;
#pragma unroll
                for (int bj = 0; bj < 2; ++bj) *(u32x4*)(rowp + bj * HALF) = pack8(acc[ai][bj][m][0], acc[ai][bj][m][1]); }
    }
};

template <class Epi, class Sched, bool ALIGN_EPI = false, bool SP2 = false, int MODE = 0  >
__device__ __forceinline__ void gemm_phase(PG8_LAS unsigned char* lds, const Gemm g, const Sched& S, const Epi& E) {
    constexpr bool FP8 = (MODE == 1), I8 = (MODE == 2);
    const int tid = threadIdx.x, wid = __builtin_amdgcn_readfirstlane(tid >> 6), lane = tid & 63, wr = wid >> 2, wc = wid & 3, fr = lane & 15, fq = lane >> 4;
    const int K = g.K, nt = (g.Kloop ? g.Kloop : K) / BK;
    unsigned voffA[2], voffB[2];
#pragma unroll
    for (int i = 0; i < 2; ++i) { int R, C; stage_rc(tid * 16 + i * 8192, R, C); const int Rb = Epi::PERM ? ((R & ~31) + perm32(R & 31)) : R;
        voffA[i] = (unsigned)(R * K + C) * 2u; voffB[i] = (unsigned)(Rb * K + C) * 2u; }
    const size_t kstep = (size_t)(BK * 2);
    const size_t hstep = (size_t)HALF * K * 2;
    const size_t tstep = 2 * hstep;
    const unsigned ldsw = (unsigned)wid * 1024u;
    const int aoff = lds_byte(wr * 64 + fr, fq * 8), boff = lds_byte(wc * 32 + fr, fq * 8);
#define PG8_SA(b, h) (((b) * 2 + (h)) * HTB)
#define PG8_SB(b, h) ((4 + (b) * 2 + (h)) * HTB)
#define PG8_STAGE(bufoff, gbase, voff) do { _Pragma("unroll") for (int _i = 0; _i < 2; ++_i) \
        __builtin_amdgcn_global_load_lds((const unsigned*)((const char*)(gbase) + (voff)[_i]), (PG8_LAS unsigned*)(lds + (bufoff) + ldsw + _i * 8192), 16, 0, 0); } while (0)
#define PG8_LDA(dst, b, h) do { _Pragma("unroll") for (int m = 0; m < 4; ++m) { if constexpr (FP8) dst##8[m] = __builtin_shufflevector(*(const PG8_LAS v4i*)(lds + PG8_SA(b, h) + aoff + m * 2048), *(const PG8_LAS v4i*)(lds + PG8_SA(b, h) + aoff + m * 2048 + 1024), 0, 1, 2, 3, 4, 5, 6, 7); \
        else { _Pragma("unroll") for (int k = 0; k < 2; ++k) dst[m][k] = *(const PG8_LAS bf16x8*)(lds + PG8_SA(b, h) + aoff + m * 2048 + k * 1024); } } } while (0)
#define PG8_LDB(dst, b, h) do { _Pragma("unroll") for (int n = 0; n < 2; ++n) { if constexpr (FP8) dst##8[n] = __builtin_shufflevector(*(const PG8_LAS v4i*)(lds + PG8_SB(b, h) + boff + n * 2048), *(const PG8_LAS v4i*)(lds + PG8_SB(b, h) + boff + n * 2048 + 1024), 0, 1, 2, 3, 4, 5, 6, 7); \
        else { _Pragma("unroll") for (int k = 0; k < 2; ++k) dst[n][k] = *(const PG8_LAS bf16x8*)(lds + PG8_SB(b, h) + boff + n * 2048 + k * 1024); } } } while (0)
#define PG8_MMA(ai, bj, At, Bt) do { __builtin_amdgcn_s_setprio(1); \
        if constexpr (FP8) { _Pragma("unroll") for (int m = 0; m < 4; ++m) _Pragma("unroll") for (int n = 0; n < 2; ++n) \
            asm volatile("v_mfma_scale_f32_16x16x128_f8f6f4 %0, %1, %2, %0, %3, %4 op_sel:[0,0,0] op_sel_hi:[0,0,0]" : "+v"(acc[ai][bj][m][n]) : "v"(Bt##8[n]), "v"(At##8[m]), "v"(scaleB8), "v"(scaleA8)); } \
        else if constexpr (I8) { _Pragma("unroll") for (int m = 0; m < 4; ++m) _Pragma("unroll") for (int n = 0; n < 2; ++n) _Pragma("unroll") for (int k = 0; k < 2; ++k) \
            acc[ai][bj][m][n] = __builtin_bit_cast(f32x4, __builtin_amdgcn_mfma_i32_16x16x64_i8(__builtin_bit_cast(v4i, Bt[n][k]), __builtin_bit_cast(v4i, At[m][k]), __builtin_bit_cast(v4i, acc[ai][bj][m][n]), 0, 0, 0)); } \
        else { _Pragma("unroll") for (int m = 0; m < 4; ++m) _Pragma("unroll") for (int n = 0; n < 2; ++n) _Pragma("unroll") for (int k = 0; k < 2; ++k) \
            acc[ai][bj][m][n] = __builtin_amdgcn_mfma_f32_16x16x32_bf16(Bt[n][k], At[m][k], acc[ai][bj][m][n], 0, 0, 0); } \
        __builtin_amdgcn_s_setprio(0); } while (0)
#define PG8_WAIT_V(n) asm volatile("s_waitcnt vmcnt(" #n ")" ::: "memory")
#define PG8_WAIT_L(n) asm volatile("s_waitcnt lgkmcnt(" #n ")" ::: "memory")
#define PG8_BAR __builtin_amdgcn_s_barrier()
#define PG8_SCHED __builtin_amdgcn_sched_barrier(0)
    Unit cur, nxt; int ui = 0;
    if (!S.next(0, cur)) return;
    f32x4 acc[2][2][4][2];
#pragma unroll
    for (int a = 0; a < 2; ++a)
#pragma unroll
        for (int b = 0; b < 2; ++b)
#pragma unroll
            for (int m = 0; m < 4; ++m)
#pragma unroll
                for (int n = 0; n < 2; ++n) acc[a][b][m][n] = (f32x4){0.f, 0.f, 0.f, 0.f};
    const int scaleB8 = (g.sB & 0xff) * 0x01010101, scaleA8 = ((g.sB >> 8) & 0xff) * 0x01010101;
    bf16x8 At[4][2], B0[2][2], B1[2][2]; v8i At8[4], B08[2], B18[2];
    const char* cA = (const char*)g.A + (size_t)cur.pm * tstep; const char* cB = (const char*)g.Bt + (size_t)cur.pn * tstep;
    S.a_ready(cur);
    if constexpr (SP2) {
        PG8_STAGE(PG8_SB(0, 0), cB, voffB); PG8_STAGE(PG8_SB(0, 1), cB + hstep, voffB); PG8_STAGE(PG8_SA(0, 0), cA, voffA); PG8_STAGE(PG8_SA(0, 1), cA + hstep, voffA);
        if (wr == 1) PG8_BAR;
        PG8_WAIT_V(2); PG8_BAR;
        PG8_STAGE(PG8_SB(1, 0), cB + kstep, voffB); PG8_STAGE(PG8_SA(1, 0), cA + kstep, voffA); PG8_STAGE(PG8_SB(1, 1), cB + hstep + kstep, voffB);
        PG8_WAIT_V(6); PG8_BAR;
    } else {
        PG8_STAGE(PG8_SB(0, 0), cB, voffB); PG8_STAGE(PG8_SA(0, 0), cA, voffA); PG8_STAGE(PG8_SB(0, 1), cB + hstep, voffB); PG8_STAGE(PG8_SA(0, 1), cA + hstep, voffA);
        if (wr == 1) PG8_BAR;
        PG8_WAIT_V(4); PG8_BAR;
        PG8_STAGE(PG8_SB(1, 0), cB + kstep, voffB); PG8_STAGE(PG8_SA(1, 0), cA + kstep, voffA); PG8_STAGE(PG8_SB(1, 1), cB + hstep + kstep, voffB);
        PG8_WAIT_V(6); PG8_BAR;
    }
    for (;;) {
        const bool has_next = S.next(ui + 1, nxt);
        const char* nA = has_next ? (const char*)g.A + (size_t)nxt.pm * tstep : cA; const char* nB = has_next ? (const char*)g.Bt + (size_t)nxt.pn * tstep : cB;
        for (int t = 0; t < nt; t += 2) {
            const bool last = (t == nt - 2);
            const char* a1 = cA + (size_t)(t + 1) * kstep;
            const char* a2 = last ? nA : cA + (size_t)(t + 2) * kstep; const char* b2 = last ? nB : cB + (size_t)(t + 2) * kstep;
            const char* a3 = a2 + kstep; const char* b3 = b2 + kstep;
            if (last && has_next) S.a_ready(nxt);
            if constexpr (SP2) {
            PG8_LDB(B0, 0, 0); PG8_LDB(B1, 0, 1); PG8_SCHED; PG8_LDA(At, 0, 0); PG8_STAGE(PG8_SA(1, 1), a1 + hstep, voffA);
            PG8_WAIT_V(8); PG8_WAIT_L(0); PG8_BAR; PG8_MMA(0, 0, At, B0); PG8_MMA(0, 1, At, B1); PG8_BAR; PG8_SCHED;
            PG8_LDA(At, 0, 1); PG8_STAGE(PG8_SB(0, 0), b2, voffB); PG8_STAGE(PG8_SB(0, 1), b2 + hstep, voffB); PG8_STAGE(PG8_SA(0, 0), a2, voffA);
            PG8_WAIT_V(8); PG8_WAIT_L(0); PG8_BAR; PG8_MMA(1, 0, At, B0); PG8_MMA(1, 1, At, B1); PG8_BAR; PG8_SCHED;
            PG8_LDB(B0, 1, 0); PG8_LDB(B1, 1, 1); PG8_SCHED; PG8_LDA(At, 1, 0); PG8_STAGE(PG8_SA(0, 1), a2 + hstep, voffA);
            PG8_WAIT_V(8); PG8_WAIT_L(0); PG8_BAR; PG8_MMA(0, 0, At, B0); PG8_MMA(0, 1, At, B1); PG8_BAR; PG8_SCHED;
            PG8_LDA(At, 1, 1); PG8_STAGE(PG8_SB(1, 0), b3, voffB); PG8_STAGE(PG8_SB(1, 1), b3 + hstep, voffB); PG8_STAGE(PG8_SA(1, 0), a3, voffA);
            PG8_WAIT_V(8); PG8_WAIT_L(0); PG8_BAR; PG8_MMA(1, 0, At, B0); PG8_MMA(1, 1, At, B1); PG8_BAR; PG8_SCHED;
            } else {
            PG8_LDB(B0, 0, 0); PG8_SCHED; PG8_LDA(At, 0, 0); PG8_STAGE(PG8_SA(1, 1), a1 + hstep, voffA);
            PG8_WAIT_L(8); PG8_BAR; PG8_WAIT_L(0); PG8_MMA(0, 0, At, B0); PG8_BAR; PG8_SCHED;
            PG8_LDB(B1, 0, 1); PG8_STAGE(PG8_SB(0, 0), b2, voffB);
            PG8_BAR; PG8_WAIT_L(0); PG8_MMA(0, 1, At, B1); PG8_BAR;
            PG8_LDA(At, 0, 1); PG8_STAGE(PG8_SA(0, 0), a2, voffA);
            PG8_BAR; PG8_WAIT_L(0); PG8_MMA(1, 0, At, B0); PG8_BAR; PG8_SCHED;
            PG8_STAGE(PG8_SB(0, 1), b2 + hstep, voffB);
            PG8_WAIT_V(6); PG8_BAR; PG8_MMA(1, 1, At, B1); PG8_BAR;
            PG8_LDB(B0, 1, 0); PG8_SCHED; PG8_LDA(At, 1, 0); PG8_STAGE(PG8_SA(0, 1), a2 + hstep, voffA);
            PG8_WAIT_L(8); PG8_BAR; PG8_WAIT_L(0); PG8_MMA(0, 0, At, B0); PG8_BAR; PG8_SCHED;
            PG8_LDB(B1, 1, 1); PG8_STAGE(PG8_SB(1, 0), b3, voffB);
            PG8_BAR; PG8_WAIT_L(0); PG8_MMA(0, 1, At, B1); PG8_BAR;
            PG8_LDA(At, 1, 1); PG8_STAGE(PG8_SA(1, 0), a3, voffA);
            PG8_BAR; PG8_WAIT_L(0); PG8_MMA(1, 0, At, B0); PG8_BAR; PG8_SCHED;
            PG8_STAGE(PG8_SB(1, 1), b3 + hstep, voffB);
            PG8_WAIT_V(6); PG8_BAR; PG8_MMA(1, 1, At, B1); PG8_BAR;
            }
        }
        if constexpr (FP8) asm volatile("s_nop 15\n\ts_nop 15" ::: "memory");
        if constexpr (ALIGN_EPI) { if (wr == 0) PG8_BAR; }
        if constexpr (!Epi::AFTER_DRAIN) { E(acc, cur, wr, wc, fr, fq); S.done(cur); }
        if (!has_next) break;
        if (E.zero_after(cur)) {
#pragma unroll
        for (int a = 0; a < 2; ++a)
#pragma unroll
            for (int b = 0; b < 2; ++b)
#pragma unroll
                for (int m = 0; m < 4; ++m)
#pragma unroll
                    for (int n = 0; n < 2; ++n) acc[a][b][m][n] = (f32x4){0.f, 0.f, 0.f, 0.f}; }
        cur = nxt; cA = nA; cB = nB; ++ui;
        if constexpr (ALIGN_EPI) { if (wr == 1) PG8_BAR; }
    }
    PG8_WAIT_V(0);
    if constexpr (!ALIGN_EPI) { if (wr == 0) PG8_BAR; }
    PG8_BAR;
    if constexpr (Epi::AFTER_DRAIN) { E.fused(acc, cur, wr, wc, fr, fq, lds, wid, lane); S.done(cur); }
#undef PG8_SA
#undef PG8_SB
#undef PG8_STAGE
#undef PG8_LDA
#undef PG8_LDB
#undef PG8_MMA
#undef PG8_WAIT_V
#undef PG8_WAIT_L
#undef PG8_BAR
#undef PG8_SCHED
}
}
#define XB_TMO      128
#define XB_XCNT(j)  (256  + 64 * (j))
#define XB_XSUB(j)  (1280 + 64 * (j))
#define XB_XGEN(j)  (2304 + 64 * (j))
#define XB_TOP      3328
#define XB_TOPGEN   3392
#define XCD_BAR_WORDS 3456
#define XB_SPIN_CAP (1u << 18)

__device__ __forceinline__ unsigned xb_ld(unsigned* p)              { return __hip_atomic_load(p, __ATOMIC_RELAXED, __HIP_MEMORY_SCOPE_AGENT); }
__device__ __forceinline__ unsigned xb_add(unsigned* p, unsigned v) { return __hip_atomic_fetch_add(p, v, __ATOMIC_RELAXED, __HIP_MEMORY_SCOPE_AGENT); }
__device__ __forceinline__ unsigned xb_xcc_id() { return (unsigned)__builtin_amdgcn_s_getreg((3 << 11) | 20) & 0xFu; }
#define XB_SPIN(cond, bar) do { unsigned _sp = 0; while (cond) { __builtin_amdgcn_s_sleep(1); \
    if ((++_sp & 255u) == 0u) { if (xb_ld(&(bar)[XB_TMO])) break; if (_sp > XB_SPIN_CAP) { atomicAdd(&(bar)[XB_TMO], 1u); break; } } } } while (0)

struct XcdBarrier {
    unsigned* bar; unsigned x;
    volatile LAS unsigned* st;
};

__device__ __forceinline__ XcdBarrier xcd_barrier_post(unsigned* bar, volatile LAS unsigned* st) {
    XcdBarrier b; b.bar = bar; b.x = xb_xcc_id(); b.st = st;
    if (threadIdx.x == 0) (void)xb_add(&bar[XB_XCNT(b.x)], 1u);
    return b;
}
__device__ __forceinline__ void xcd_barrier_complete(unsigned* bar, unsigned x, unsigned& nloc, unsigned& nx) {
    const unsigned G = gridDim.x * gridDim.y * gridDim.z;
    unsigned sum, cnt, mine, sp = 0u;
    for (;;) {
        sum = 0u; cnt = 0u; mine = 0u;
#pragma unroll
        for (unsigned j = 0; j < 16; ++j) { const unsigned c = xb_ld(&bar[XB_XCNT(j)]); sum += c; cnt += (c > 0u) ? 1u : 0u; mine = (j == x) ? c : mine; }
        if (sum == G) break;
        __builtin_amdgcn_s_sleep(1);
        if ((++sp & 255u) == 0u) { if (xb_ld(&bar[XB_TMO])) break; if (sp > XB_SPIN_CAP) { atomicAdd(&bar[XB_TMO], 1u); break; } }
    }
    nloc = mine > 0u ? mine : 1u; nx = cnt > 0u ? cnt : 1u;
}

__device__ __forceinline__ void xcd_barrier(const XcdBarrier& b) {
    asm volatile("s_waitcnt vmcnt(0)" ::: "memory");
    __syncthreads();
    if (threadIdx.x == 0) {
        unsigned* bar = b.bar;
        __builtin_amdgcn_s_waitcnt(0);
        unsigned nloc = b.st[0], nx = b.st[1];
        if (nloc == 0u) { xcd_barrier_complete(bar, b.x, nloc, nx); b.st[0] = nloc; b.st[1] = nx; }
        const unsigned old = xb_add(&bar[XB_XSUB(b.x)], 1u);
        const unsigned gen = old / nloc;
        if (old + 1u == (gen + 1u) * nloc) {
            __builtin_amdgcn_fence(__ATOMIC_RELEASE, "agent");
            asm volatile("s_waitcnt vmcnt(0)" ::: "memory");
            const unsigned og = xb_add(&bar[XB_TOP], 1u);
            const unsigned tg = og / nx;
            if (og + 1u == (tg + 1u) * nx) xb_add(&bar[XB_TOPGEN], 1u);
            else XB_SPIN(xb_ld(&bar[XB_TOPGEN]) == tg, bar);
            __builtin_amdgcn_fence(__ATOMIC_ACQUIRE, "agent");
            xb_add(&bar[XB_XGEN(b.x)], 1u);
            asm volatile("s_waitcnt vmcnt(0)" ::: "memory");
        } else {
            XB_SPIN(xb_ld(&bar[XB_XGEN(b.x)]) == gen, bar);
            __builtin_amdgcn_fence(__ATOMIC_ACQUIRE, "agent");
            asm volatile("s_waitcnt vmcnt(0)" ::: "memory");
        }
    }
    __syncthreads();
}

typedef pg8::bf16_t bf16_t;
typedef pg8::f32x4 f32x4;
typedef pg8::bf16x8 bf16x8;
__device__ __forceinline__ unsigned f2bf(float f) { unsigned u = __builtin_bit_cast(unsigned, f); return (u + 0x7fffu + ((u >> 16) & 1u)) >> 16; }
__device__ __forceinline__ unsigned pk2(float lo, float hi) { return f2bf(lo) | (f2bf(hi) << 16); }
__device__ __forceinline__ float wave_sum(float v) {
#pragma unroll
    for (int o = 1; o < 64; o <<= 1) v += __shfl_xor(v, o);
    return v;
}
__device__ __forceinline__ void lds_add(LAS int* p, int v) { (void)__hip_atomic_fetch_add(p, v, __ATOMIC_RELAXED, __HIP_MEMORY_SCOPE_WORKGROUP); }
__device__ __forceinline__ float bf_lo(unsigned w) { return __uint_as_float(w << 16); }
__device__ __forceinline__ float bf_hi(unsigned w) { return __uint_as_float(w & 0xffff0000u); }

__device__ __forceinline__ void p0_mod(LAS unsigned char* lds, const float* cvec, const float* ada_w, const float* ada_b, float* MOD, int G) {
    LAS float* sc = (LAS float*)lds;
    LAS float* red = (LAS float*)(lds + 32768);
    const int tid = threadIdx.x, lane = tid & 63, wave = tid >> 6;
    for (int i = tid; i < NBATCH * D; i += 512) { const float v = cvec[i]; sc[i] = v / (1.0f + __expf(-v)); }
    __syncthreads();
    for (int it = blockIdx.x; it < 2 * (MODW / 32); it += G) {
        const int l = it / (MODW / 32), n0 = (it % (MODW / 32)) * 32, kp = lane >> 3, cq = lane & 7;
        const GAS f32x4* W = (const GAS f32x4*)(ada_w + (size_t)l * D * MODW + n0 + 4 * cq);
        f32x4 a0 = {0.f, 0.f, 0.f, 0.f}, a1 = a0, a2 = a0, a3 = a0;
        const int k0 = wave * 256 + kp;
        for (int kk = k0; kk < k0 + 256; kk += 128) {
            f32x4 w[16];
#pragma unroll
            for (int u = 0; u < 16; ++u) w[u] = W[(size_t)(kk + 8 * u) * (MODW / 4)];
#pragma unroll
            for (int u = 0; u < 16; ++u) { const int k = kk + 8 * u; a0 += w[u] * sc[k]; a1 += w[u] * sc[D + k]; a2 += w[u] * sc[2 * D + k]; a3 += w[u] * sc[3 * D + k]; }
        }
#pragma unroll
        for (int o = 8; o < 64; o <<= 1) {
#pragma unroll
            for (int c = 0; c < 4; ++c) { a0[c] += __shfl_xor(a0[c], o); a1[c] += __shfl_xor(a1[c], o); a2[c] += __shfl_xor(a2[c], o); a3[c] += __shfl_xor(a3[c], o); } }
        if (lane < 8) { *(LAS f32x4*)(red + (wave * 4 + 0) * 32 + 4 * lane) = a0; *(LAS f32x4*)(red + (wave * 4 + 1) * 32 + 4 * lane) = a1; *(LAS f32x4*)(red + (wave * 4 + 2) * 32 + 4 * lane) = a2; *(LAS f32x4*)(red + (wave * 4 + 3) * 32 + 4 * lane) = a3; }
        __syncthreads();
        if (wave < 4 && lane < 32) { float s = 0.f;
#pragma unroll
            for (int w2 = 0; w2 < 8; ++w2) s += red[(w2 * 4 + wave) * 32 + lane];
            MOD[(size_t)(l * NBATCH + wave) * MODW + n0 + lane] = s + ada_b[l * MODW + n0 + lane]; }
        __syncthreads();
    }
}
__device__ __forceinline__ int win_src_col(int dg) {
    const int pn = dg >> 3, wi = dg & 7;
    if (pn < 5) return 256 * pn + 64 * (wi & 3) + 32 * (wi >> 2);
    if (pn < 10) return 32 * dg;
    if (pn < 18) return 2560 + (wi >> 2) * 1024 + (pn - 10) * 128 + (wi & 3) * 32;
    return 4608 + (wi >> 2) * 2048 + (pn - 18) * 128 + (wi & 3) * 32;
}
__device__ __forceinline__ int gu_src_col(int dg, int F) { const int pn = dg >> 3, wi = dg & 7; return (wi >> 2) * F + pn * 128 + (wi & 3) * 32; }

struct Wts { const float *w_in, *w_ab, *w_cb, *w_out, *ffn_gu, *ffn_dn, *moe_gu, *moe_dn; bf16_t *WAC, *WOUT; unsigned char *WIN, *WGU, *WDN, *MGU, *MDN; };
struct TrDesc { const float* src; unsigned char* dst; int N, pitch, mode; float scale; };
__device__ __forceinline__ TrDesc tr_decode(const Wts& w, int it) {
    constexpr int I_WIN = (D / 64) * (DIN / 32), I_AC = (DATT / 64) * (D / 32), I_OUT = (D / 64) * (D / 32), I_GU = (D / 64) * (2 * DFF / 32), I_DN = (DFF / 64) * (D / 32),
                  I_MGU = (D / 64) * (2 * MFF / 32), I_MDN = (MFF / 64) * (D / 32);
    TrDesc d; int r = it;
    if (r < 2 * I_WIN) { const int l = r / I_WIN, rr = r % I_WIN, kb = rr % (D / 64), dg = rr / (D / 64);
        d.src = w.w_in + (size_t)l * D * DIN + (size_t)(64 * kb) * DIN + win_src_col(dg); d.N = DIN; d.pitch = D; d.mode = 2; d.scale = W8I_SCALE; d.dst = w.WIN + (size_t)l * DIN * D + (size_t)(32 * dg) * D + 64 * kb; return d; }
    r -= 2 * I_WIN;
    if (r < 4 * I_AC) { const int mi = r / I_AC, rr = r % I_AC, l = mi >> 1, which = mi & 1, kb = rr % (DATT / 64), dg = rr / (DATT / 64);
        d.src = (which ? w.w_cb : w.w_ab) + (size_t)l * DATT * D + (size_t)(64 * kb) * D + 32 * dg; d.N = D; d.pitch = DATT * 2; d.mode = 0; d.scale = 1.0f; d.dst = (unsigned char*)(w.WAC + (size_t)mi * D * DATT + (size_t)(32 * dg) * DATT + 64 * kb); return d; }
    r -= 4 * I_AC;
    if (r < 2 * I_OUT) { const int l = r / I_OUT, rr = r % I_OUT, kb = rr % (D / 64), dg = rr / (D / 64);
        d.src = w.w_out + (size_t)l * D * D + (size_t)(64 * kb) * D + 32 * dg; d.N = D; d.pitch = D * 2; d.mode = 0; d.scale = 1.0f; d.dst = (unsigned char*)(w.WOUT + (size_t)l * D * D + (size_t)(32 * dg) * D + 64 * kb); return d; }
    r -= 2 * I_OUT;
    if (r < I_GU) { const int kb = r % (D / 64), dg = r / (D / 64);
        d.src = w.ffn_gu + (size_t)(64 * kb) * (2 * DFF) + gu_src_col(dg, DFF); d.N = 2 * DFF; d.pitch = D; d.mode = 2; d.scale = W8I_SCALE; d.dst = w.WGU + (size_t)(32 * dg) * D + 64 * kb; return d; }
    r -= I_GU;
    if (r < I_DN) { const int kb = r % (DFF / 64), dg = r / (DFF / 64);
        d.src = w.ffn_dn + (size_t)(64 * kb) * D + 32 * dg; d.N = D; d.pitch = DFF; d.mode = 1; d.scale = (float)(1 << MDN8_LOG2); d.dst = w.WDN + (size_t)(32 * dg) * DFF + 64 * kb; return d; }
    r -= I_DN;
    if (r < NEXP * I_MGU) { const int e = r / I_MGU, rr = r % I_MGU, kb = rr % (D / 64), dg = rr / (D / 64);
        d.src = w.moe_gu + (size_t)e * D * 2 * MFF + (size_t)(64 * kb) * (2 * MFF) + gu_src_col(dg, MFF); d.N = 2 * MFF; d.pitch = D; d.mode = 2; d.scale = W8I_SCALE; d.dst = w.MGU + (size_t)e * 2 * MFF * D + (size_t)(32 * dg) * D + 64 * kb; return d; }
    r -= NEXP * I_MGU;
    { const int e = r / I_MDN, rr = r % I_MDN, kb = rr % (MFF / 64), dg = rr / (MFF / 64);
        d.src = w.moe_dn + (size_t)e * MFF * D + (size_t)(64 * kb) * D + 32 * dg; d.N = D; d.pitch = MFF; d.mode = 1; d.scale = (float)(1 << MDN8_LOG2); d.dst = w.MDN + (size_t)e * D * MFF + (size_t)(32 * dg) * MFF + 64 * kb; return d; }
}
__device__ __forceinline__ void tr_load(const TrDesc& d, int lane, f32x4 (&a)[8]) {
    const GAS f32x4* src = (const GAS f32x4*)(d.src + (size_t)(8 * (lane >> 3)) * d.N + 4 * (lane & 7));
#pragma unroll
    for (int i = 0; i < 8; ++i) a[i] = src[(size_t)i * (d.N / 4)];
}
__device__ __forceinline__ void tr_store(const TrDesc& d, int lane, const f32x4 (&a)[8]) {
    const int kb = lane >> 3, nq = lane & 7;
#pragma unroll
    for (int c = 0; c < 4; ++c) {
        unsigned char* p = d.dst + (size_t)(4 * nq + c) * d.pitch;
        if (d.mode == 0) { v4u o; o.x = pk2(a[0][c], a[1][c]); o.y = pk2(a[2][c], a[3][c]); o.z = pk2(a[4][c], a[5][c]); o.w = pk2(a[6][c], a[7][c]); *(GAS v4u*)(p + 16 * kb) = o; }
        else { v2u o; const float sc = d.scale;
            if (d.mode == 2) { o.x = pg8::pk4_i8(a[0][c] * sc, a[1][c] * sc, a[2][c] * sc, a[3][c] * sc); o.y = pg8::pk4_i8(a[4][c] * sc, a[5][c] * sc, a[6][c] * sc, a[7][c] * sc); }
            else { o.x = pg8::pk4_fp8(a[0][c] * sc, a[1][c] * sc, a[2][c] * sc, a[3][c] * sc); o.y = pg8::pk4_fp8(a[4][c] * sc, a[5][c] * sc, a[6][c] * sc, a[7][c] * sc); }
            *(GAS v2u*)(p + 8 * kb) = o; }
    }
}
__device__ __forceinline__ void p0_convert(LAS unsigned char* lds, const Wts& w, int vcu, int G) {
    const int lane = threadIdx.x & 63, wave = threadIdx.x >> 6;
    const int gw = vcu * 8 + wave, NGW = G * 8;
    constexpr int NITEMS = 2 * (D / 64) * (DIN / 32) + 4 * (DATT / 64) * (D / 32) + 2 * (D / 64) * (D / 32);
    static_assert(NITEMS % 2 == 0, "items come in k-block pairs");
    int it = 2 * gw; if (it >= NITEMS) return;
    TrDesc p0 = tr_decode(w, it), p1 = tr_decode(w, it + 1), q0 = p0, q1 = p1; f32x4 a0[8], a1[8], b0[8], b1[8];
    tr_load(p0, lane, a0); tr_load(p1, lane, a1);
    for (;;) {
        it += 2 * NGW; const bool hq = it < NITEMS;
        if (hq) { q0 = tr_decode(w, it); q1 = tr_decode(w, it + 1); tr_load(q0, lane, b0); tr_load(q1, lane, b1); }
        tr_store(p0, lane, a0); tr_store(p1, lane, a1);
        if (!hq) break;
        it += 2 * NGW; const bool hp = it < NITEMS;
        if (hp) { p0 = tr_decode(w, it); p1 = tr_decode(w, it + 1); tr_load(p0, lane, a0); tr_load(p1, lane, a1); }
        tr_store(q0, lane, b0); tr_store(q1, lane, b1);
        if (!hp) break;
    }
}

struct TileDesc { const float* src; unsigned char* dst; int N, pitch, hstride, mode; float scale; };
__device__ __forceinline__ TileDesc tile_decode(const Wts& w, int t) {
    constexpr int T_GU = (D / 128) * (2 * DFF / 256), T_DN = (DFF / 128) * (D / 256), T_MGU = (D / 128) * (2 * MFF / 256), T_MDN = (MFF / 128) * (D / 256);
    TileDesc d; int r = t;
    if (r < T_GU) { const int kt = r % (D / 128), ct = r / (D / 128), col0 = 256 * ct, up = col0 >= DFF ? 1 : 0, j = (col0 - up * DFF) / 256;
        d.src = w.ffn_gu + (size_t)(128 * kt) * (2 * DFF) + col0; d.N = 2 * DFF; d.pitch = D; d.hstride = 256; d.mode = 2; d.scale = W8I_SCALE; d.dst = w.WGU + (size_t)(512 * j + 128 * up) * D + 128 * kt; return d; }
    r -= T_GU;
    if (r < T_DN) { const int kt = r % (DFF / 128), ct = r / (DFF / 128);
        d.src = w.ffn_dn + (size_t)(128 * kt) * D + 256 * ct; d.N = D; d.pitch = DFF; d.hstride = 128; d.mode = 1; d.scale = (float)(1 << MDN8_LOG2); d.dst = w.WDN + (size_t)(256 * ct) * DFF + 128 * kt; return d; }
    r -= T_DN;
    if (r < NEXP * T_MGU) { const int e = r / T_MGU, rr = r % T_MGU, kt = rr % (D / 128), ct = rr / (D / 128), col0 = 256 * ct, up = col0 >= MFF ? 1 : 0, j = (col0 - up * MFF) / 256;
        d.src = w.moe_gu + (size_t)e * D * 2 * MFF + (size_t)(128 * kt) * (2 * MFF) + col0; d.N = 2 * MFF; d.pitch = D; d.hstride = 256; d.mode = 2; d.scale = W8I_SCALE;
        d.dst = w.MGU + (size_t)e * 2 * MFF * D + (size_t)(512 * j + 128 * up) * D + 128 * kt; return d; }
    r -= NEXP * T_MGU;
    { const int e = r / T_MDN, rr = r % T_MDN, kt = rr % (MFF / 128), ct = rr / (MFF / 128);
        d.src = w.moe_dn + (size_t)e * MFF * D + (size_t)(128 * kt) * D + 256 * ct; d.N = D; d.pitch = MFF; d.hstride = 128; d.mode = 1; d.scale = (float)(1 << MDN8_LOG2);
        d.dst = w.MDN + (size_t)e * D * MFF + (size_t)(256 * ct) * MFF + 128 * kt; return d; }
}
__device__ __forceinline__ void tile_load(const TileDesc& d, int wave, int lane, f32x4 (&a)[16]) {
    const GAS f32x4* src = (const GAS f32x4*)(d.src + (size_t)(16 * wave) * d.N + 4 * lane);
#pragma unroll
    for (int i = 0; i < 16; ++i) a[i] = src[(size_t)i * (d.N / 4)];
}
__device__ __forceinline__ void tile_to_lds(const TileDesc& d, LAS unsigned char* buf, int wave, int lane, const f32x4 (&a)[16]) {
    const float sc = d.scale;
#pragma unroll
    for (int c = 0; c < 4; ++c) {
        v4u o;
        if (d.mode == 2) { o.x = pg8::pk4_i8(a[0][c] * sc, a[1][c] * sc, a[2][c] * sc, a[3][c] * sc); o.y = pg8::pk4_i8(a[4][c] * sc, a[5][c] * sc, a[6][c] * sc, a[7][c] * sc);
                           o.z = pg8::pk4_i8(a[8][c] * sc, a[9][c] * sc, a[10][c] * sc, a[11][c] * sc); o.w = pg8::pk4_i8(a[12][c] * sc, a[13][c] * sc, a[14][c] * sc, a[15][c] * sc); }
        else { o.x = pg8::pk4_fp8(a[0][c] * sc, a[1][c] * sc, a[2][c] * sc, a[3][c] * sc); o.y = pg8::pk4_fp8(a[4][c] * sc, a[5][c] * sc, a[6][c] * sc, a[7][c] * sc);
               o.z = pg8::pk4_fp8(a[8][c] * sc, a[9][c] * sc, a[10][c] * sc, a[11][c] * sc); o.w = pg8::pk4_fp8(a[12][c] * sc, a[13][c] * sc, a[14][c] * sc, a[15][c] * sc); }
        const int n = 4 * lane + c, pos = (((n & 1) << 3) + wave) ^ (lane & 15);
        *(LAS v4u*)(buf + (n >> 1) * 256 + 16 * pos) = o;
    }
}
__device__ __forceinline__ void tile_store(const TileDesc& d, const LAS unsigned char* buf, int tid) {
#pragma unroll
    for (int j = 0; j < 4; ++j) {
        const int row = j * 64 + (tid >> 3), ch = tid & 7, pos = (((row & 1) << 3) + ch) ^ ((row >> 2) & 15);
        const v4u v = *(const LAS v4u*)(buf + (row >> 1) * 256 + 16 * pos);
        *(GAS v4u*)(d.dst + (size_t)((row >> 7) * d.hstride + (row & 127)) * d.pitch + 16 * ch) = v;
    }
}
constexpr int NT_FFN = (D / 128) * (2 * DFF / 256) + (DFF / 128) * (D / 256), NQ_MOE = NEXP * ((D / 128) * (2 * MFF / 256) + (MFF / 128) * (D / 256));
__device__ __forceinline__ void p0_convert_tiles(LAS unsigned char* lds, const Wts& w, int vcu, int G) {
    constexpr int NT = NT_FFN;
    const int tid = threadIdx.x, lane = tid & 63, wave = __builtin_amdgcn_readfirstlane(tid >> 6);
    __syncthreads();
    int t = vcu; if (t >= NT) return;
    TileDesc p = tile_decode(w, t), q = p; f32x4 a[16], b[16];
    tile_load(p, wave, lane, a);
    for (;;) {
        t += G; const bool hq = t < NT;
        if (hq) { q = tile_decode(w, t); tile_load(q, wave, lane, b); }
        tile_to_lds(p, lds, wave, lane, a); __syncthreads(); tile_store(p, lds, tid);
        if (!hq) break;
        t += G; const bool hp = t < NT;
        if (hp) { p = tile_decode(w, t); tile_load(p, wave, lane, a); }
        tile_to_lds(q, lds + 32768, wave, lane, b); __syncthreads(); tile_store(q, lds + 32768, tid);
        if (!hp) break;
    }
    __syncthreads();
}

struct Args { const float* in[19]; float* out; unsigned char* ws; int ph_lo, ph_hi; };
constexpr int NQ_ALL = NT_FFN + NQ_MOE;
constexpr int NQ_GU_END = NT_FFN + NEXP * (D / 128) * (2 * MFF / 256);
constexpr int QMB_OFF = LDSCTL_OFF + 2560;
__device__ __forceinline__ TileDesc moe_tile_decode(const Args& args, int tq) {
    constexpr int T_GU = (D / 128) * (2 * DFF / 256), T_DN = (DFF / 128) * (D / 256), T_MGU = (D / 128) * (2 * MFF / 256);
    int r = tq, cls = 0;
    if (r >= T_GU) { r -= T_GU; cls = 1; if (r >= T_DN) { r -= T_DN; cls = 2; if (r >= NEXP * T_MGU) { r -= NEXP * T_MGU; cls = 3; } } }
    const bool isgu = (cls & 1) == 0; const int F = cls < 2 ? DFF : MFF;
    const int per = isgu ? (D / 128) * (2 * F / 256) : (F / 128) * (D / 256), nk = isgu ? D / 128 : F / 128;
    const int e = r / per, rr = r % per, kt = rr % nk, ct = rr / nk, col0 = 256 * ct, up = (isgu && col0 >= F) ? 1 : 0, j = (col0 - up * F) / 256;
    const size_t N = isgu ? 2 * F : D, pitch = isgu ? D : F, esz = isgu ? (size_t)D * 2 * F : (size_t)F * D;
    const GAS float* sb = (const GAS float*)(cls == 0 ? args.in[14] : cls == 1 ? args.in[15] : cls == 2 ? args.in[17] : args.in[18]);
    const size_t doff = cls == 0 ? WS_WGU : cls == 1 ? WS_WDN : cls == 2 ? WS_MGU : WS_MDN;
    GAS unsigned char* db = (GAS unsigned char*)args.ws + doff;
    TileDesc p;
    p.src = (const float*)(sb + (size_t)e * esz + (size_t)(128 * kt) * N + col0); p.N = (int)N; p.pitch = (int)pitch; p.hstride = isgu ? 256 : 128; p.mode = isgu ? 2 : 1;
    p.scale = isgu ? W8I_SCALE : (float)(1 << MDN8_LOG2);
    p.dst = (unsigned char*)(db + (size_t)e * esz + (isgu ? (size_t)(512 * j + 128 * up) * D : (size_t)(256 * ct) * F) + 128 * kt);
    return p;
}
__device__ __forceinline__ void convert_tiles(LAS unsigned char* lds, const Args& m, int tq, int n) {
    const int tid = threadIdx.x, lane = tid & 63, wave = __builtin_amdgcn_readfirstlane(tid >> 6);
    const TileDesc p = moe_tile_decode(m, tq); f32x4 a[16];
    tile_load(p, wave, lane, a);
    if (n == 2) {
        const TileDesc q = moe_tile_decode(m, tq + 1); f32x4 b2[16];
        tile_load(q, wave, lane, b2);
        tile_to_lds(p, lds, wave, lane, a); __syncthreads(); tile_store(p, lds, tid);
        tile_to_lds(q, lds + 32768, wave, lane, b2); __syncthreads(); tile_store(q, lds + 32768, tid); __syncthreads();
    } else { tile_to_lds(p, lds, wave, lane, a); __syncthreads(); tile_store(p, lds, tid); __syncthreads(); }
}
__device__ __forceinline__ void moe_tiles_rest(LAS unsigned char* lds, const Args& m, unsigned* qctr, unsigned limit) {
    volatile LAS unsigned* mb = (volatile LAS unsigned*)(lds + QMB_OFF);
    for (;;) {
        __syncthreads();
        if (threadIdx.x == 0) { unsigned t = 0xffffffffu;
            if (mb[3] == 0u && xb_ld(qctr) < limit) { t = xb_add(qctr, 2u); if (t >= (unsigned)NQ_ALL) { t = 0xffffffffu; mb[3] = 1u; } }
            mb[1] = t; }
        __syncthreads();
        const unsigned t = mb[1];
        if (t == 0xffffffffu) break;
        convert_tiles(lds, m, (int)t, (t + 1u < (unsigned)NQ_ALL) ? 2 : 1);
    }
    __syncthreads();
}
__device__ __forceinline__ void xcd_barrier_work(const XcdBarrier& b, LAS unsigned char* lds, const Args& m, unsigned* qctr) {
    volatile LAS unsigned* mb = (volatile LAS unsigned*)(lds + QMB_OFF);
    asm volatile("s_waitcnt vmcnt(0)" ::: "memory");
    __syncthreads();
    unsigned gen = 0u;
    if (threadIdx.x == 0) {
        unsigned* bar = b.bar;
        __builtin_amdgcn_s_waitcnt(0);
        unsigned nloc = b.st[0], nx = b.st[1];
        if (nloc == 0u) { xcd_barrier_complete(bar, b.x, nloc, nx); b.st[0] = nloc; b.st[1] = nx; }
        const unsigned old = xb_add(&bar[XB_XSUB(b.x)], 1u);
        gen = old / nloc;
        if (old + 1u == (gen + 1u) * nloc) {
            __builtin_amdgcn_fence(__ATOMIC_RELEASE, "agent");
            asm volatile("s_waitcnt vmcnt(0)" ::: "memory");
            const unsigned og = xb_add(&bar[XB_TOP], 1u);
            const unsigned tg = og / nx;
            if (og + 1u == (tg + 1u) * nx) xb_add(&bar[XB_TOPGEN], 1u);
            else XB_SPIN(xb_ld(&bar[XB_TOPGEN]) == tg, bar);
            __builtin_amdgcn_fence(__ATOMIC_ACQUIRE, "agent");
            xb_add(&bar[XB_XGEN(b.x)], 1u);
            asm volatile("s_waitcnt vmcnt(0)" ::: "memory");
            mb[0] = 1u;
        } else if (mb[3] != 0u) {
            XB_SPIN(xb_ld(&bar[XB_XGEN(b.x)]) == gen, bar);
            __builtin_amdgcn_fence(__ATOMIC_ACQUIRE, "agent");
            asm volatile("s_waitcnt vmcnt(0)" ::: "memory");
            mb[0] = 1u;
        } else mb[0] = 0u;
    }
    __syncthreads();
    if (mb[0] == 0u) {
        unsigned sp = 0u, held = 0xffffffffu;
        for (;;) {
            if (threadIdx.x == 0) {
                unsigned* bar = b.bar;
                const unsigned xg = xb_ld(&bar[XB_XGEN(b.x)]);
                unsigned done = (xg != gen) ? 1u : 0u, t = held;
                if (t == 0xffffffffu && !done && mb[3] == 0u) { t = xb_add(qctr, 2u); if (t >= (unsigned)NQ_ALL) { t = 0xffffffffu; mb[3] = 1u; } }
                if (t == 0xffffffffu && !done) { __builtin_amdgcn_s_sleep(1); if ((++sp & 255u) == 0u) { if (xb_ld(&bar[XB_TMO])) done = 1u; else if (sp > XB_SPIN_CAP) { atomicAdd(&bar[XB_TMO], 1u); done = 1u; } } }
                const unsigned fin = (done && t == 0xffffffffu) ? 1u : 0u;
                if (fin) { __builtin_amdgcn_fence(__ATOMIC_ACQUIRE, "agent"); asm volatile("s_waitcnt vmcnt(0)" ::: "memory"); }
                mb[0] = fin; mb[1] = t; mb[2] = (t != 0xffffffffu && t + 2u <= (unsigned)NQ_ALL) ? 2u : 1u; mb[4] = done;
                held = 0xffffffffu;
            }
            __syncthreads();
            const unsigned fin = mb[0], t = mb[1], cnt = mb[2], rel = mb[4];
            __syncthreads();
            if (fin) break;
            if (t != 0xffffffffu) {
                unsigned nx = 0xffffffffu;
                if (threadIdx.x == 0 && !rel && mb[3] == 0u) nx = xb_add(qctr, 2u);
                convert_tiles(lds, m, (int)t, (int)cnt);
                if (threadIdx.x == 0 && nx != 0xffffffffu) { if (nx >= (unsigned)NQ_ALL) mb[3] = 1u; else held = nx; }
            }
        }
    }
    __syncthreads();
}

template <bool MOE, bool XBF16>
__device__ __forceinline__ void norm_phase(LAS unsigned char* lds, const void* X, const float* gain, const float* scale, const float* shift, unsigned char* H, float* SA,
                                           const float* Wr, int* TOKE, float* TOKW, int* CNT, int G) {
    LAS float* tabA = (LAS float*)lds; LAS float* tabB = (LAS float*)(lds + 8192); LAS float* WrT = (LAS float*)(lds + 16384); LAS int* cnt = (LAS int*)(lds + 16384 + 65536);
    const int tid = threadIdx.x, lane = tid & 63, wave = tid >> 6;
    if (MOE) { for (int i = tid; i < D * NEXP; i += 512) WrT[(i & 7) * D + (i >> 3)] = Wr[i]; }
    for (int rb = blockIdx.x; rb < T / 64; rb += G) {
        const int b = rb >> 6;
        for (int i = tid; i < D; i += 512) { tabA[i] = gain[i] * (1.0f + scale[(size_t)b * MODW + i]); tabB[i] = shift[(size_t)b * MODW + i]; }
        if (MOE && tid < 8) cnt[tid] = 0;
        __syncthreads();
        v2u rawb[8]; f32x4 rawf[8];
        { const size_t r0 = (size_t)rb * 64 + wave * 8;
#pragma unroll
          for (int j = 0; j < 8; ++j) { if (XBF16) rawb[j] = ((const GAS v2u*)((const bf16_t*)X + r0 * D))[lane + 64 * j]; else rawf[j] = ((const GAS f32x4*)((const float*)X + r0 * D))[lane + 64 * j]; } }
        for (int i = 0; i < 8; ++i) {
            const size_t row = (size_t)rb * 64 + wave * 8 + i;
            const size_t rnx = row + 1 < (size_t)T ? row + 1 : row;
            f32x4 v[8]; float ss = 0.f;
#pragma unroll
            for (int j = 0; j < 8; ++j) {
                if (XBF16) { const v2u w2 = rawb[j]; v[j] = (f32x4){bf_lo(w2.x), bf_hi(w2.x), bf_lo(w2.y), bf_hi(w2.y)}; rawb[j] = ((const GAS v2u*)((const bf16_t*)X + rnx * D))[lane + 64 * j]; }
                else { v[j] = rawf[j]; rawf[j] = ((const GAS f32x4*)((const float*)X + rnx * D))[lane + 64 * j]; }
                ss += (v[j][0] * v[j][0] + v[j][1] * v[j][1]) + (v[j][2] * v[j][2] + v[j][3] * v[j][3]); }
            const float rinv = 1.0f / sqrtf(wave_sum(ss) * (1.0f / D) + EPS);
            float amax = 0.f;
#pragma unroll
            for (int j = 0; j < 8; ++j) { const f32x4 a = *(const LAS f32x4*)(tabA + 4 * lane + 256 * j), bb = *(const LAS f32x4*)(tabB + 4 * lane + 256 * j);
                v[j] = v[j] * rinv * a + bb; amax = fmaxf(fmaxf(amax, fmaxf(fabsf(v[j][0]), fabsf(v[j][1]))), fmaxf(fabsf(v[j][2]), fabsf(v[j][3]))); }
#pragma unroll
            for (int o = 1; o < 64; o <<= 1) amax = fmaxf(amax, __shfl_xor(amax, o));
            const float qs = amax > 0.f ? 127.0f / amax : 0.f;
#pragma unroll
            for (int j = 0; j < 8; ++j) ((GAS unsigned*)(H + row * D))[lane + 64 * j] = pg8::pk4_i8(v[j][0] * qs, v[j][1] * qs, v[j][2] * qs, v[j][3] * qs);
            if (lane == 0) SA[row] = amax * (1.0f / 127.0f);
            if (MOE) {
                float lg[8];
#pragma unroll
                for (int e = 0; e < 8; ++e) { float s = 0.f;
#pragma unroll
                    for (int j = 0; j < 8; ++j) { const f32x4 w4 = *(const LAS f32x4*)(WrT + e * D + 4 * lane + 256 * j); s += (v[j][0] * w4[0] + v[j][1] * w4[1]) + (v[j][2] * w4[2] + v[j][3] * w4[3]); }
                    lg[e] = wave_sum(s); }
                int e0 = 0; float v0 = lg[0];
#pragma unroll
                for (int e = 1; e < 8; ++e) if (lg[e] > v0) { v0 = lg[e]; e0 = e; }
                int e1 = -1; float v1 = -3.0e38f;
#pragma unroll
                for (int e = 0; e < 8; ++e) if (e != e0 && lg[e] > v1) { v1 = lg[e]; e1 = e; }
                const float w0 = 1.0f / (1.0f + __expf(v1 - v0));
                if (lane == 0) { TOKE[2 * row] = e0; TOKE[2 * row + 1] = e1; TOKW[2 * row] = w0; TOKW[2 * row + 1] = 1.0f - w0; lds_add((cnt + e0), 1); lds_add((cnt + e1), 1); }
            }
        }
        __syncthreads();
        if (MOE && tid < 8) CNT[rb * 8 + tid] = cnt[tid];
        __syncthreads();
    }
}

__device__ __forceinline__ void moe_slots(LAS unsigned char* lds, const unsigned char* H, const float* SA, const int* TOKE, const int* CNT, int* SLOT, int* GT, unsigned char* XG, float* SAg, int G) {
    LAS int* tot = (LAS int*)lds; LAS int* pre = tot + 8; LAS int* basee = tot + 16; LAS int* padn = tot + 24; LAS int* pads = tot + 32; LAS int* eArr = tot + 64; LAS int* sArr = tot + 192;
    const int tid = threadIdx.x, lane = tid & 63, wave = tid >> 6;
    for (int rb = blockIdx.x; rb < T / 64; rb += G) {
        if (tid < 16) tot[tid] = 0;
        __syncthreads();
        { const int wq = tid >> 1, hf = tid & 1; const int4 c4 = *(const int4*)(CNT + wq * 8 + hf * 4); const bool lt = wq < rb;
          lds_add((tot + hf * 4 + 0), c4.x); lds_add((tot + hf * 4 + 1), c4.y); lds_add((tot + hf * 4 + 2), c4.z); lds_add((tot + hf * 4 + 3), c4.w);
          if (lt) { lds_add((pre + hf * 4 + 0), c4.x); lds_add((pre + hf * 4 + 1), c4.y); lds_add((pre + hf * 4 + 2), c4.z); lds_add((pre + hf * 4 + 3), c4.w); } }
        __syncthreads();
        if (tid == 0) { int rt = 0;
            for (int e = 0; e < 8; ++e) { const int n = (tot[e] + 255) >> 8; basee[e] = rt * 256 + pre[e]; pads[e] = rt * 256 + tot[e]; padn[e] = n * 256 - tot[e];
                if (rb == 0) { GT[e] = rt; GT[8 + e] = n; } rt += n; } }
        if (tid < 128) eArr[tid] = TOKE[(size_t)rb * 128 + tid];
        __syncthreads();
        if (tid < 128) { const int e = eArr[tid]; int rank = 0; for (int p = 0; p < tid; ++p) rank += (eArr[p] == e) ? 1 : 0;
            const int slot = basee[e] + rank; sArr[tid] = slot; SLOT[(size_t)rb * 128 + tid] = slot; SAg[slot] = SA[(size_t)rb * 64 + (tid >> 1)]; }
        __syncthreads();
        for (int tk = wave * 8; tk < wave * 8 + 8; tk += 4) {
            v4u a[4][2];
#pragma unroll
            for (int q = 0; q < 4; ++q) { const GAS v4u* s = (const GAS v4u*)(H + ((size_t)rb * 64 + tk + q) * D) + lane; a[q][0] = s[0]; a[q][1] = s[64]; }
#pragma unroll
            for (int q = 0; q < 4; ++q) {
                GAS v4u* d0 = (GAS v4u*)(XG + (size_t)sArr[2 * (tk + q)] * D) + lane; GAS v4u* d1 = (GAS v4u*)(XG + (size_t)sArr[2 * (tk + q) + 1] * D) + lane;
                d0[0] = a[q][0]; d0[64] = a[q][1]; d1[0] = a[q][0]; d1[64] = a[q][1]; }
        }
        if (rb < padn[wave]) { GAS v4u* d = (GAS v4u*)(XG + (size_t)(pads[wave] + rb) * D) + lane; const v4u z = {0u, 0u, 0u, 0u}; d[0] = z; d[64] = z; if (lane == 0) SAg[pads[wave] + rb] = 0.f; }
        __syncthreads();
    }
}
constexpr int SLOT_SPLIT = 128 * 256; constexpr size_t YP_STRIDE = (size_t)8 * 256 * D;
__device__ __forceinline__ f32x4 load_y4(const bf16_t* Y, const bf16_t* YP, int slot, int idx) {
    if (slot < SLOT_SPLIT) { const v2u a = ((const GAS v2u*)(Y + (size_t)slot * D))[idx]; return (f32x4){bf_lo(a.x), bf_hi(a.x), bf_lo(a.y), bf_hi(a.y)}; }
    f32x4 r = {0.f, 0.f, 0.f, 0.f};
#pragma unroll
    for (int p = 0; p < 4; ++p) { const v2u a = ((const GAS v2u*)(YP + p * YP_STRIDE + (size_t)(slot - SLOT_SPLIT) * D))[idx]; r += (f32x4){bf_lo(a.x), bf_hi(a.x), bf_lo(a.y), bf_hi(a.y)}; }
    return r;
}
__device__ __forceinline__ void moe_combine(const bf16_t* X1, const bf16_t* Y, const bf16_t* YP, const int* SLOT, const float* TOKW, const float* gate, float* out, int vcu, int G) {
    const int lane = threadIdx.x & 63, wave = threadIdx.x >> 6;
    for (int row = vcu * 8 + wave; row < T; row += G * 8) {
        const int s0 = SLOT[2 * row], s1 = SLOT[2 * row + 1]; const float w0 = TOKW[2 * row], w1 = TOKW[2 * row + 1];
        const GAS v2u* x = (const GAS v2u*)(X1 + (size_t)row * D) + lane;
        const GAS f32x4* g = (const GAS f32x4*)(gate + (size_t)(row >> 12) * MODW) + lane; GAS f32x4* o = (GAS f32x4*)(out + (size_t)row * D) + lane;
        if (s0 < SLOT_SPLIT && s1 < SLOT_SPLIT) {
            const GAS v2u* y0 = (const GAS v2u*)(Y + (size_t)s0 * D) + lane; const GAS v2u* y1 = (const GAS v2u*)(Y + (size_t)s1 * D) + lane;
#pragma unroll
            for (int j = 0; j < 8; ++j) { const v2u a = y0[64 * j], b = y1[64 * j];
                const f32x4 ya = {bf_lo(a.x), bf_hi(a.x), bf_lo(a.y), bf_hi(a.y)}, yb = {bf_lo(b.x), bf_hi(b.x), bf_lo(b.y), bf_hi(b.y)};
                const v2u xw = x[64 * j]; const f32x4 xv = {bf_lo(xw.x), bf_hi(xw.x), bf_lo(xw.y), bf_hi(xw.y)};
                o[64 * j] = xv + g[64 * j] * (ya * w0 + yb * w1); }
        } else {
            const bool sp0 = s0 >= SLOT_SPLIT, sp1 = s1 >= SLOT_SPLIT;
            const GAS v2u* p0 = (const GAS v2u*)(sp0 ? YP + (size_t)(s0 - SLOT_SPLIT) * D : Y + (size_t)s0 * D) + lane; const size_t st0 = sp0 ? YP_STRIDE / 4 : 0;
            const GAS v2u* p1 = (const GAS v2u*)(sp1 ? YP + (size_t)(s1 - SLOT_SPLIT) * D : Y + (size_t)s1 * D) + lane; const size_t st1 = sp1 ? YP_STRIDE / 4 : 0;
            const float m0 = sp0 ? w0 : 0.f, m1 = sp1 ? w1 : 0.f;
#pragma unroll
            for (int j = 0; j < 8; ++j) { f32x4 acc4 = {0.f, 0.f, 0.f, 0.f};
#pragma unroll
                for (int p = 0; p < 4; ++p) { const v2u a = p0[64 * j + p * st0], b = p1[64 * j + p * st1]; const float wa = p ? m0 : w0, wb = p ? m1 : w1;
                    acc4 += (f32x4){bf_lo(a.x), bf_hi(a.x), bf_lo(a.y), bf_hi(a.y)} * wa + (f32x4){bf_lo(b.x), bf_hi(b.x), bf_lo(b.y), bf_hi(b.y)} * wb; }
                const v2u xw = x[64 * j]; const f32x4 xv = {bf_lo(xw.x), bf_hi(xw.x), bf_lo(xw.y), bf_hi(xw.y)};
                o[64 * j] = xv + g[64 * j] * acc4; }
        }
    }
}

__device__ __forceinline__ void attn_conv_phase(LAS unsigned char* lds, const bf16_t* Q, const bf16_t* Kb, const bf16_t* Vb, const bf16_t* BC, const bf16_t* U, const float* convw, const float* sinks,
                                                bf16_t* AC, int G) {
    constexpr int KSTR = 144, VSTR = 560;
    LAS unsigned char* Ks = lds; LAS unsigned char* Vt = lds + 256 * KSTR;
    const int tid = threadIdx.x, lane = tid & 63, wave = tid >> 6, fr = lane & 15, fq = lane >> 4;
    for (int unit = blockIdx.x; unit < NBATCH * 32 * 4; unit += G) {
        const int kvh = unit & 3, nb = (unit >> 2) & 31, b = unit >> 7;
        const long tok0 = (long)b * SEQ + nb * 128 - 128;
        __syncthreads();
#pragma unroll
        for (int i = 0; i < 4; ++i) { const int task = tid + 512 * i, krel = task >> 3, ch = task & 7; v4u val = {0u, 0u, 0u, 0u};
            if (nb > 0 || krel >= 128) val = *(const GAS v4u*)(Kb + (size_t)(tok0 + krel) * DKV + kvh * 64 + ch * 8);
            *(LAS v4u*)(Ks + krel * KSTR + ch * 16) = val; }
#pragma unroll
        for (int i = 0; i < 4; ++i) { const int task = tid + 512 * i, krel = task & 255, ch = task >> 8; v4u val = {0u, 0u, 0u, 0u};
            if (nb > 0 || krel >= 128) val = *(const GAS v4u*)(Vb + (size_t)(tok0 + krel) * DKV + kvh * 64 + ch * 8);
            LAS unsigned short* vp = (LAS unsigned short*)(Vt + (ch * 8) * VSTR + krel * 2);
            vp[0 * (VSTR / 2)] = (unsigned short)(val.x & 0xffffu); vp[1 * (VSTR / 2)] = (unsigned short)(val.x >> 16); vp[2 * (VSTR / 2)] = (unsigned short)(val.y & 0xffffu); vp[3 * (VSTR / 2)] = (unsigned short)(val.y >> 16);
            vp[4 * (VSTR / 2)] = (unsigned short)(val.z & 0xffffu); vp[5 * (VSTR / 2)] = (unsigned short)(val.z >> 16); vp[6 * (VSTR / 2)] = (unsigned short)(val.w & 0xffffu); vp[7 * (VSTR / 2)] = (unsigned short)(val.w >> 16); }
        { const int d = tid >> 3, c = tid & 7; *(LAS unsigned*)(Vt + d * VSTR + 512 + c * 4) = 0u; }
        const int hq = kvh * 4 + (wave >> 1), half = wave & 1;
        const bf16_t* qbase = Q + ((size_t)b * SEQ + nb * 128 + half * 64 + fr) * DATT + hq * 64 + fq * 8;
        bf16x8 qn0 = *(const GAS bf16x8*)qbase, qn1 = *(const GAS bf16x8*)(qbase + 32);
        __syncthreads();
        const float slope2 = __builtin_amdgcn_exp2f(-0.5f * (float)(hq + 1)) * LOG2E, sink2 = sinks[hq] * LOG2E;
        for (int st = 0; st < 4; ++st) {
            const int i0 = half * 64 + st * 16, t0 = i0 >> 4;
            const size_t qrow = (size_t)b * SEQ + nb * 128 + i0 + fr;
            const bf16x8 qf0 = qn0, qf1 = qn1;
            if (st < 3) { qn0 = *(const GAS bf16x8*)(qbase + (size_t)(st + 1) * 16 * DATT); qn1 = *(const GAS bf16x8*)(qbase + (size_t)(st + 1) * 16 * DATT + 32); }
            f32x4 S[9];
#pragma unroll
            for (int tt = 0; tt < 9; ++tt) { const LAS unsigned char* kp = Ks + (16 * (t0 + tt) + fr) * KSTR + fq * 16;
                const bf16x8 k0 = *(const LAS bf16x8*)kp, k1 = *(const LAS bf16x8*)(kp + 64);
                f32x4 s = {0.f, 0.f, 0.f, 0.f};
                s = __builtin_amdgcn_mfma_f32_16x16x32_bf16(k0, qf0, s, 0, 0, 0); s = __builtin_amdgcn_mfma_f32_16x16x32_bf16(k1, qf1, s, 0, 0, 0); S[tt] = s; }
            const int df = fr - 4 * fq; float mx = sink2;
#pragma unroll
            for (int tt = 0; tt < 9; ++tt)
#pragma unroll
                for (int j = 0; j < 4; ++j) { const int dist = 128 - 16 * tt + df - j; bool valid = true;
                    if (tt == 0) valid = (df - j) < 0; if (tt == 8) valid = (df - j) >= 0; if (nb == 0 && t0 + tt < 8) valid = false;
                    const float lg = valid ? (S[tt][j] - slope2 * (float)dist) : -__builtin_inff(); S[tt][j] = lg; mx = fmaxf(mx, lg); }
            mx = fmaxf(mx, __shfl_xor(mx, 16)); mx = fmaxf(mx, __shfl_xor(mx, 32));
            float lsum = 0.f;
#pragma unroll
            for (int tt = 0; tt < 9; ++tt)
#pragma unroll
                for (int j = 0; j < 4; ++j) { const float p = __builtin_amdgcn_exp2f(S[tt][j] - mx); S[tt][j] = p; lsum += p; }
            lsum += __shfl_xor(lsum, 16); lsum += __shfl_xor(lsum, 32); lsum += __builtin_amdgcn_exp2f(sink2 - mx);
            const float inv = 1.0f / lsum;
            f32x4 O[4];
#pragma unroll
            for (int dt = 0; dt < 4; ++dt) O[dt] = (f32x4){0.f, 0.f, 0.f, 0.f};
#pragma unroll
            for (int uu = 0; uu < 5; ++uu) {
                v4u pw; pw.x = pg8::cvt_pk_bf16(S[2 * uu][0], S[2 * uu][1]); pw.y = pg8::cvt_pk_bf16(S[2 * uu][2], S[2 * uu][3]);
                if (uu < 4) { pw.z = pg8::cvt_pk_bf16(S[2 * uu + 1 > 8 ? 8 : 2 * uu + 1][0], S[2 * uu + 1 > 8 ? 8 : 2 * uu + 1][1]); pw.w = pg8::cvt_pk_bf16(S[2 * uu + 1 > 8 ? 8 : 2 * uu + 1][2], S[2 * uu + 1 > 8 ? 8 : 2 * uu + 1][3]); }
                else { pw.z = 0u; pw.w = 0u; }
                const bf16x8 pb = __builtin_bit_cast(bf16x8, pw);
#pragma unroll
                for (int dt = 0; dt < 4; ++dt) { const LAS unsigned char* vp = Vt + (16 * dt + fr) * VSTR + (16 * (t0 + 2 * uu) + 4 * fq) * 2;
                    const s16x4 lo = *(const LAS s16x4*)vp, hi = *(const LAS s16x4*)(vp + 32);
                    const bf16x8 va = __builtin_shufflevector(lo, hi, 0, 1, 2, 3, 4, 5, 6, 7);
                    O[dt] = __builtin_amdgcn_mfma_f32_16x16x32_bf16(va, pb, O[dt], 0, 0, 0); }
            }
            bf16_t* op = AC + qrow * DATT + hq * 64 + 4 * fq;
#pragma unroll
            for (int dt = 0; dt < 4; ++dt) { v2u o; o.x = pg8::cvt_pk_bf16(O[dt][0] * inv, O[dt][1] * inv); o.y = pg8::cvt_pk_bf16(O[dt][2] * inv, O[dt][3] * inv); *(GAS v2u*)(op + 16 * dt) = o; }
        }
    }
    bf16_t* CO = AC + (size_t)T * DATT;
    for (int rb = blockIdx.x; rb < T / 64; rb += G) {
#pragma unroll 4
        for (int i = 0; i < 16; ++i) { const int task = tid + 512 * i; const size_t row = (size_t)rb * 64 + (task >> 7); const int ch0 = (task & 127) * 8, tseq = (int)(row & (SEQ - 1));
            const v4u z = {0u, 0u, 0u, 0u};
            const v4u u0 = *(const GAS v4u*)(U + row * DCONV + ch0), u1 = tseq >= 1 ? *(const GAS v4u*)(U + (row - 1) * DCONV + ch0) : z, u2 = tseq >= 2 ? *(const GAS v4u*)(U + (row - 2) * DCONV + ch0) : z;
            const v4u bc = *(const GAS v4u*)(BC + row * DCONV + ch0);
            f32x4 a0, b0, a1, b1, a2, b2, ab, bb; pg8::unpack8(u0, a0, b0); pg8::unpack8(u1, a1, b1); pg8::unpack8(u2, a2, b2); pg8::unpack8(bc, ab, bb);
            const f32x4 w0a = *(const f32x4*)(convw + ch0), w0b = *(const f32x4*)(convw + ch0 + 4), w1a = *(const f32x4*)(convw + DCONV + ch0), w1b = *(const f32x4*)(convw + DCONV + ch0 + 4),
                        w2a = *(const f32x4*)(convw + 2 * DCONV + ch0), w2b = *(const f32x4*)(convw + 2 * DCONV + ch0 + 4);
            const f32x4 ya = ab * (w0a * a2 + w1a * a1 + w2a * a0), yb = bb * (w0b * b2 + w1b * b1 + w2b * b0);
            *(GAS v4u*)(CO + row * DCONV + ch0) = pg8::pack8(ya, yb); }
    }
}

constexpr int N_PHASES = 19;
#define RUN(k) (lo <= (k) && (k) < hi)
#define SEAM(k) do { if (RUN(k) && RUN((k) + 1)) { XcdBarrier b2_ = bar; unsigned char* ws_ = WSB(); b2_.bar = (unsigned*)(ws_ + WS_CTL) + CW_BAR; xcd_barrier_work(b2_, lds, args, (unsigned*)(ws_ + WS_CTL + 49152)); } } while (0)
#define WSB() ({ GAS unsigned char* _w = (GAS unsigned char*)args.ws; asm volatile("" : "+s"(_w)); (unsigned char*)_w; })
#define INP(i) ((const float*)(const GAS float*)args.in[i])
#define WP(type, off) ((type*)(ws + (off)))
template <int l>
__device__ __forceinline__ void layer_phases(const Args& args, LAS unsigned char* lds, const XcdBarrier& bar, const int lo, const int hi, const int G, const int bx, const int vcu) {
        const int pb = l * 8;
        if (RUN(pb + 1)) { unsigned char* ws = WSB(); const float* modl = WP(float, WS_MOD) + (size_t)l * NBATCH * MODW;
            if (l == 0) norm_phase<false, false>(lds, INP(0), INP(4) + l * D, modl + 1 * D, modl + 0 * D, WP(unsigned char, WS_H), WP(float, WS_MOE + 458752), nullptr, nullptr, nullptr, nullptr, G);
            else norm_phase<false, true>(lds, WP(bf16_t, WS_X2), INP(4) + l * D, modl + 1 * D, modl + 0 * D, WP(unsigned char, WS_H), WP(float, WS_MOE + 458752), nullptr, nullptr, nullptr, nullptr, G); }
        SEAM(pb + 1);
        if (RUN(pb + 2)) { unsigned char* ws = WSB();
            pg8::Gemm g{WP(bf16_t, WS_H), (const bf16_t*)(WP(unsigned char, WS_WIN) + (size_t)l * DIN * D), T, DIN, D / 2}; pg8::StaticOrder S; S.init(T, DIN, G, bx);
            pg8::EpiWin E{WP(bf16_t, WS_Q), WP(bf16_t, WS_K), WP(bf16_t, WS_V), WP(bf16_t, WS_BC), WP(bf16_t, WS_U), WP(bf16_t, WS_R), WP(bf16_t, WS_GC), INP(6) + l * 64, INP(7) + l * 64, WP(float, WS_MOE + 458752), 1.0f / W8I_SCALE};
            pg8::gemm_phase<pg8::EpiWin, pg8::StaticOrder, true, true, 2>(lds, g, S, E);
        }
        SEAM(pb + 2);
        if (RUN(pb + 3)) { unsigned char* ws = WSB();
            attn_conv_phase(lds, WP(bf16_t, WS_Q), WP(bf16_t, WS_K), WP(bf16_t, WS_V), WP(bf16_t, WS_BC), WP(bf16_t, WS_U), INP(9) + (size_t)l * 3 * DCONV, INP(8) + l * 16, WP(bf16_t, WS_AC), G); }
        SEAM(pb + 3);
        if (RUN(pb + 4)) { unsigned char* ws = WSB();
            pg8::Gemm g{WP(bf16_t, WS_AC), WP(bf16_t, WS_WAC) + (size_t)l * 2 * D * DATT, 2 * T, 2 * D, DATT}; pg8::MergeOrder S; S.init(G, bx);
            pg8::EpiMerge E{WP(bf16_t, WS_R), WP(bf16_t, WS_GC), WP(bf16_t, WS_MG)};
            pg8::gemm_phase<pg8::EpiMerge, pg8::MergeOrder, true, true>(lds, g, S, E);
        }
        SEAM(pb + 4);
        if (RUN(pb + 5)) { unsigned char* ws = WSB(); const float* modl = WP(float, WS_MOD) + (size_t)l * NBATCH * MODW;
            pg8::Gemm g{WP(bf16_t, WS_MG), WP(bf16_t, WS_WOUT) + (size_t)l * D * D, T, D, D}; pg8::StaticOrder S; S.init(T, D, G, bx);
            if (l == 0) { pg8::EpiResid<false> E{INP(0), WP(bf16_t, WS_X1), modl + 2 * D}; pg8::gemm_phase<pg8::EpiResid<false>, pg8::StaticOrder, true, true>(lds, g, S, E); }
            else { pg8::EpiResid<true> E{WP(bf16_t, WS_X2), WP(bf16_t, WS_X1), modl + 2 * D}; pg8::gemm_phase<pg8::EpiResid<true>, pg8::StaticOrder, true, true>(lds, g, S, E); }
        }
        SEAM(pb + 5);
        if (RUN(pb + 6)) { unsigned char* ws = WSB(); const float* modl = WP(float, WS_MOD) + (size_t)l * NBATCH * MODW;
            if (l == 0) norm_phase<false, true>(lds, WP(bf16_t, WS_X1), INP(13) + l * D, modl + 4 * D, modl + 3 * D, WP(unsigned char, WS_H), WP(float, WS_MOE + 458752), nullptr, nullptr, nullptr, nullptr, G);
            else        norm_phase<true, true>(lds, WP(bf16_t, WS_X1), INP(13) + l * D, modl + 4 * D, modl + 3 * D, WP(unsigned char, WS_H), WP(float, WS_MOE + 458752), INP(16), WP(int, WS_MOE + 65536), WP(float, WS_MOE + 196608), WP(int, WS_MOE), G);
        }
        if (l == 0 && RUN(pb + 6)) { unsigned char* ws = WSB(); moe_tiles_rest(lds, args, WP(unsigned, WS_CTL + 49152), (unsigned)NT_FFN); }
        SEAM(pb + 6);
        if constexpr (l == 0) {
            if (RUN(7)) { unsigned char* ws = WSB();
                pg8::Gemm g{WP(bf16_t, WS_H), WP(bf16_t, WS_WGU), T, 2 * DFF, D / 2}; pg8::StaticOrder S; S.init(T, 2 * DFF, G, bx);
                pg8::EpiSwiglu8 E{WP(unsigned char, WS_ACT), DFF, 2 * DFF / 256, WP(float, WS_MOE + 458752), 1.0f / W8I_SCALE};
                pg8::gemm_phase<pg8::EpiSwiglu8, pg8::StaticOrder, true, true, 2>(lds, g, S, E);
            }
            SEAM(7);
            if (RUN(8)) { unsigned char* ws = WSB(); const float* modl = WP(float, WS_MOD);
                pg8::Gemm g{WP(bf16_t, WS_ACT), WP(bf16_t, WS_WDN), T, D, DFF / 2, ((127 - 2) << 8) | (127 - MDN8_LOG2)}; pg8::StaticOrder S; S.init(T, D, G, bx);
                pg8::EpiResid<true> E{WP(bf16_t, WS_X1), WP(bf16_t, WS_X2), modl + 5 * D};
                pg8::gemm_phase<pg8::EpiResid<true>, pg8::StaticOrder, true, true, 1>(lds, g, S, E);
            }
            SEAM(8);
        } else {
            if (RUN(15)) { unsigned char* ws = WSB(); moe_slots(lds, WP(unsigned char, WS_H), WP(float, WS_MOE + 458752), WP(int, WS_MOE + 65536), WP(int, WS_MOE), WP(int, WS_MOE + 327680), WP(int, WS_MOE + 16384), WP(unsigned char, WS_XG), WP(float, WS_MOE + 524288), G); }
            if (RUN(15)) { unsigned char* ws = WSB(); moe_tiles_rest(lds, args, WP(unsigned, WS_CTL + 49152), (unsigned)NQ_GU_END); }
            SEAM(15);
            if (RUN(16)) { unsigned char* ws = WSB();
                pg8::Gemm g{WP(bf16_t, WS_XG), WP(bf16_t, WS_MGU), NSLOT, NEXP * 2 * MFF, D / 2}; pg8::GroupedOrder S; S.init((LAS int*)(lds + LDSCTL_OFF + 1024), WP(int, WS_MOE + 16384), 2 * MFF / 256, G, bx);
                pg8::EpiSwiglu8 E{WP(unsigned char, WS_ACT), MFF, 2 * MFF / 256, WP(float, WS_MOE + 524288), 1.0f / W8I_SCALE};
                pg8::gemm_phase<pg8::EpiSwiglu8, pg8::GroupedOrder, true, true, 2>(lds, g, S, E);
                moe_tiles_rest(lds, args, WP(unsigned, WS_CTL + 49152), (unsigned)NQ_ALL);
            }
            SEAM(16);
            if (RUN(17)) { unsigned char* ws = WSB();
                pg8::GroupedOrder S0; S0.init((LAS int*)(lds + LDSCTL_OFF + 1024), WP(int, WS_MOE + 16384), D / 256, G, bx);
                const int ntiles = S0.total / (D / 256);
                { pg8::Gemm g{WP(bf16_t, WS_ACT), WP(bf16_t, WS_MDN), NSLOT, NEXP * D, MFF / 2, ((127 - 2) << 8) | (127 - MDN8_LOG2)};
                  pg8::DownMainOrder S; S.init((LAS int*)(lds + LDSCTL_OFF + 1024), G, bx);
                  pg8::EpiY E{WP(bf16_t, WS_Y), 0};
                  pg8::gemm_phase<pg8::EpiY, pg8::DownMainOrder, true, true, 1>(lds, g, S, E); }
                { const size_t koff = (size_t)(bx & 3) * (MFF / 4);
                  pg8::Gemm g{(const bf16_t*)(WP(unsigned char, WS_ACT) + koff), (const bf16_t*)(WP(unsigned char, WS_MDN) + koff), NSLOT, NEXP * D, MFF / 2, ((127 - 2) << 8) | (127 - MDN8_LOG2), MFF / 8};
                  pg8::DownSpillOrder S; S.init((LAS int*)(lds + LDSCTL_OFF + 1024), bx, ntiles);
                  pg8::EpiY E{WP(bf16_t, WS_Y + 136 * MiB) + (size_t)(bx & 3) * YP_STRIDE, 128};
                  pg8::gemm_phase<pg8::EpiY, pg8::DownSpillOrder, true, true, 1>(lds, g, S, E); }
            }
            SEAM(17);
            if (RUN(18)) { unsigned char* ws = WSB(); const float* modl = WP(float, WS_MOD) + (size_t)NBATCH * MODW;
                moe_combine(WP(bf16_t, WS_X1), WP(bf16_t, WS_Y), WP(bf16_t, WS_Y + 136 * MiB), WP(int, WS_MOE + 327680), WP(float, WS_MOE + 196608), modl + 5 * D, args.out, vcu, G); }
        }
}
__global__ void __launch_bounds__(512, 2) mk_fwd(Args args) {
    extern __shared__ __attribute__((aligned(16))) unsigned char lds_raw[];
    LAS unsigned char* lds = (LAS unsigned char*)lds_raw;
    const int tid = threadIdx.x;
    const int G = gridDim.x; const int bx = blockIdx.x; const int vcu = (G % 8 == 0) ? (bx % 8) * (G / 8) + bx / 8 : bx;
    unsigned* ctl = (unsigned*)(GAS unsigned*)(args.ws + WS_CTL);
    for (int u = tid; u < (LDS_BYTES - LDSCTL_OFF) / 4; u += 512) ((LAS unsigned*)(lds + LDSCTL_OFF))[u] = 0u;
    __syncthreads();
    XcdBarrier bar = xcd_barrier_post(ctl + CW_BAR, (volatile LAS unsigned*)(lds + MISC_OFF) + 8);
    const int lo = args.ph_lo, hi = args.ph_hi;


    if (RUN(0)) {
        unsigned char* ws = WSB();
        p0_mod(lds, INP(1), INP(2), INP(3), WP(float, WS_MOD), G);
        Wts w; w.w_in = INP(5); w.w_ab = INP(10); w.w_cb = INP(11); w.w_out = INP(12); w.ffn_gu = INP(14); w.ffn_dn = INP(15); w.moe_gu = INP(17); w.moe_dn = INP(18);
        w.WIN = WP(unsigned char, WS_WIN); w.WAC = WP(bf16_t, WS_WAC); w.WOUT = WP(bf16_t, WS_WOUT); w.WGU = WP(unsigned char, WS_WGU); w.WDN = WP(unsigned char, WS_WDN); w.MGU = WP(unsigned char, WS_MGU); w.MDN = WP(unsigned char, WS_MDN);
        p0_convert(lds, w, vcu, G);
    }
    SEAM(0);
    layer_phases<0>(args, lds, bar, lo, hi, G, bx, vcu);
    layer_phases<1>(args, lds, bar, lo, hi, G, bx, vcu);
}

extern "C" void kernel_launch(void* const* d_in, const int* in_sizes, int n_in, void* d_out, int out_size, void* d_ws, size_t ws_size, hipStream_t stream) {
    static int grid = 0;
    if (grid == 0) {
        if (n_in != 19 || in_sizes[0] != T * D || out_size != T * D || ws_size < WS_END) { fprintf(stderr, "kernel_launch: unexpected problem (n_in %d, x %d, out %d, ws %zu < %zu); nothing launched\n", n_in, n_in > 0 ? in_sizes[0] : -1, out_size, ws_size, (size_t)WS_END); grid = -1; return; }
        int dev = 0, cus = 0, per_cu = 0;
        if (hipGetDevice(&dev) != hipSuccess || hipDeviceGetAttribute(&cus, hipDeviceAttributeMultiprocessorCount, dev) != hipSuccess) { fprintf(stderr, "kernel_launch: device query failed\n"); grid = -1; return; }
        if (hipFuncSetAttribute((const void*)mk_fwd, hipFuncAttributeMaxDynamicSharedMemorySize, LDS_BYTES) != hipSuccess) { fprintf(stderr, "kernel_launch: hipFuncSetAttribute failed\n"); grid = -1; return; }
        if (hipOccupancyMaxActiveBlocksPerMultiprocessor(&per_cu, (const void*)mk_fwd, 512, LDS_BYTES) != hipSuccess || per_cu < 1) fprintf(stderr, "kernel_launch: note: occupancy query reports %d workgroups per CU\n", per_cu);
        (void)hipGetLastError();
        grid = cus;
    }
    if (grid < 0) return;
    if (hipMemsetAsync((char*)d_ws + WS_CTL, 0, CTL_ZERO_BYTES, stream) != hipSuccess) { fprintf(stderr, "kernel_launch: memset failed\n"); return; }
    Args a{};
    for (int i = 0; i < 19; ++i) a.in[i] = (const float*)d_in[i];
    a.out = (float*)d_out; a.ws = (unsigned char*)d_ws;
#if MK_N_LAUNCHES == 1
    a.ph_lo = 0; a.ph_hi = N_PHASES;
    hipLaunchKernelGGL(mk_fwd, dim3(grid), dim3(512), LDS_BYTES, stream, a);
#else
    for (int p = 0; p < N_PHASES; ++p) { a.ph_lo = p; a.ph_hi = p + 1; const int reps = ((MK_PROBE_MASK >> p) & 1) ? 2 : 1;
        for (int r = 0; r < reps; ++r) hipLaunchKernelGGL(mk_fwd, dim3(grid), dim3(512), LDS_BYTES, stream, a); }
#endif
    const hipError_t le = hipPeekAtLastError();
    if (le != hipSuccess) fprintf(stderr, "kernel_launch: launch failed: %s\n", hipGetErrorName(le));
}
```

```cpp
#include <hip/hip_runtime.h>
#include <cstdio>
#include <cstdint>

#ifndef MK_PROBE_MASK
#define MK_PROBE_MASK 0
#endif
#ifndef MK_N_LAUNCHES
#define MK_N_LAUNCHES 1
#endif

constexpr int T = 16384, SEQ = 4096, NBATCH = 4, D = 2048, DIN = 8704, DATT = 1024, DKV = 256, DCONV = 1024, DFF = 5632, MFF = 7168, NEXP = 8;
constexpr int MODW = 6 * D;
constexpr int NSLOT = 2 * T + NEXP * 256;
constexpr float EPS = 1e-6f;
constexpr float LOG2E = 1.4426950408889634f;
constexpr float ACT8_SCALE = 4.0f;
constexpr int MDN8_LOG2 = 7;
constexpr float W8I_SCALE = 1448.0f;
constexpr float QSCALE = 0.125f * LOG2E;

constexpr size_t MiB = (size_t)1 << 20;
constexpr size_t WS_CTL = 0, CTL_ZERO_BYTES = 1 * MiB;
constexpr size_t WS_MOD = 1 * MiB;
constexpr size_t WS_MOE = 2 * MiB;
constexpr size_t WS_WIN = 4 * MiB;
constexpr size_t WS_WAC = 72 * MiB;
constexpr size_t WS_WOUT = 88 * MiB;
constexpr size_t WS_WGU = 104 * MiB;
constexpr size_t WS_WDN = 148 * MiB;
constexpr size_t WS_MGU = 170 * MiB;
constexpr size_t WS_MDN = 618 * MiB;
constexpr size_t WS_H = 842 * MiB;
constexpr size_t WS_Q = 906 * MiB;
constexpr size_t WS_K = 938 * MiB;
constexpr size_t WS_V = 946 * MiB;
constexpr size_t WS_BC = 954 * MiB;
constexpr size_t WS_U = 986 * MiB;
constexpr size_t WS_R = 1018 * MiB;
constexpr size_t WS_GC = 1082 * MiB;
constexpr size_t WS_AC = 1146 * MiB;
constexpr size_t WS_MG = 1210 * MiB;
constexpr size_t WS_X1 = 1274 * MiB;
constexpr size_t WS_X2 = 1402 * MiB;
constexpr size_t WS_ACT = 1530 * MiB;
constexpr size_t WS_XG = 2006 * MiB;
constexpr size_t WS_Y = 2142 * MiB;
constexpr size_t WS_END = 2414 * MiB;
constexpr int CW_BAR = 4096;

constexpr int RING_BYTES = 131072;
constexpr int LDSCTL_OFF = RING_BYTES, MISC_OFF = LDSCTL_OFF + 320;
constexpr int LDS_BYTES = 147456;

#define GAS __attribute__((address_space(1)))
#define LAS __attribute__((address_space(3)))
typedef unsigned v4u __attribute__((ext_vector_type(4)));
typedef unsigned v2u __attribute__((ext_vector_type(2)));
typedef short s16x4 __attribute__((ext_vector_type(4)));
#define LDS_WAIT() asm volatile("s_waitcnt lgkmcnt(0)" ::: "memory")
#define VM_WAIT() asm volatile("s_waitcnt vmcnt(0)" ::: "memory")

namespace pg8 {
#define PG8_LAS __attribute__((address_space(3)))
typedef unsigned short bf16_t;
typedef short bf16x8 __attribute__((ext_vector_type(8)));
typedef float f32x4 __attribute__((ext_vector_type(4)));
typedef unsigned u32x4 __attribute__((ext_vector_type(4)));
constexpr int BM = 256, BK = 64, HALF = 128, HTB = HALF * BK * 2  , STAGE_BYTES = 8 * HTB, NXCD = 8, WGM = 4;

__host__ __device__ __forceinline__ int lds_byte(int r, int c) { const int st = (r >> 4) * 2 + (c >> 5), rr = r & 15, cc = c & 31, ob = rr * 64 + cc * 2; return st * 1024 + (ob ^ (((ob >> 9) & 1) << 5)); }
__host__ __device__ __forceinline__ void stage_rc(int b, int& R, int& C) { const int st = b / 1024, sb = b % 1024, swz = sb ^ (((sb >> 9) & 1) << 5); R = (st >> 1) * 16 + swz / 64; C = (st & 1) * 32 + (swz % 64) / 2; }
__host__ __device__ __forceinline__ int perm32(int rho) { const int n = rho >> 4, i = rho & 15; return 8 * (i >> 2) + 4 * n + (i & 3); }

struct Unit { int pm, pn; };
struct Gemm { const bf16_t* A; const bf16_t* Bt; int M, N, K; int sB = 0x7f7f; int Kloop = 0; };
typedef int v8i __attribute__((ext_vector_type(8)));
typedef int v4i __attribute__((ext_vector_type(4)));

struct StaticOrder {
    int nM, nN, nwg, G, c;
    __host__ __device__ void init(int M, int N, int G_, int c_) { nM = M / BM; nN = N / BM; nwg = nM * nN; G = G_; c = c_; }
    __host__ __device__ bool next(int i, Unit& u) const {
        const long L = (long)i * G + c; if (L >= nwg) return false;
        int wgid = (int)L; { const int q = nwg / NXCD, r = nwg % NXCD, xcd = wgid % NXCD, off = wgid / NXCD; wgid = (xcd < r ? xcd * (q + 1) : r * (q + 1) + (xcd - r) * q) + off; }
        const int nig = WGM * nN, gid = wgid / nig, fm = gid * WGM, gsz = (nM - fm) < WGM ? (nM - fm) : WGM;
        u.pm = fm + ((wgid % nig) % gsz); u.pn = (wgid % nig) / gsz; return true;
    }
    __device__ __forceinline__ void a_ready(const Unit&) const {}
    __device__ __forceinline__ void done(const Unit&) const {}
};

__device__ __forceinline__ unsigned cvt_pk_bf16(float lo, float hi) { unsigned r; asm volatile("v_cvt_pk_bf16_f32 %0, %1, %2" : "=v"(r) : "v"(lo), "v"(hi)); return r; }
__device__ __forceinline__ u32x4 pack8(const f32x4 a, const f32x4 b) { u32x4 w; w.x = cvt_pk_bf16(a[0], a[1]); w.y = cvt_pk_bf16(a[2], a[3]); w.z = cvt_pk_bf16(b[0], b[1]); w.w = cvt_pk_bf16(b[2], b[3]); return w; }
__device__ __forceinline__ void unpack8(const u32x4 w, f32x4& a, f32x4& b) {
    a[0] = __uint_as_float(w.x << 16); a[1] = __uint_as_float(w.x & 0xffff0000u); a[2] = __uint_as_float(w.y << 16); a[3] = __uint_as_float(w.y & 0xffff0000u);
    b[0] = __uint_as_float(w.z << 16); b[1] = __uint_as_float(w.z & 0xffff0000u); b[2] = __uint_as_float(w.w << 16); b[3] = __uint_as_float(w.w & 0xffff0000u); }
__device__ __forceinline__ float fast_exp(float x) { return __builtin_amdgcn_exp2f(x * 1.4426950408889634f); }
__device__ __forceinline__ float sigmoid_f(float x) { return __builtin_amdgcn_rcpf(1.0f + fast_exp(-x)); }
__device__ __forceinline__ unsigned pk4_i8(float a, float b, float c, float d) {
    const int ia = (int)__builtin_rintf(__builtin_amdgcn_fmed3f(a, -127.0f, 127.0f)), ib = (int)__builtin_rintf(__builtin_amdgcn_fmed3f(b, -127.0f, 127.0f)),
              ic = (int)__builtin_rintf(__builtin_amdgcn_fmed3f(c, -127.0f, 127.0f)), id = (int)__builtin_rintf(__builtin_amdgcn_fmed3f(d, -127.0f, 127.0f));
    return ((unsigned)ia & 0xffu) | (((unsigned)ib & 0xffu) << 8) | (((unsigned)ic & 0xffu) << 16) | ((unsigned)id << 24); }
__device__ __forceinline__ void acc_i32_to_f32(f32x4 (&acc)[2][2][4][2], const float* rowscale, size_t row0, float wsc) {
#pragma unroll
    for (int ai = 0; ai < 2; ++ai)
#pragma unroll
        for (int m = 0; m < 4; ++m) { const float rs = rowscale[row0 + ai * HALF + m * 16] * wsc;
#pragma unroll
            for (int bj = 0; bj < 2; ++bj)
#pragma unroll
                for (int n = 0; n < 2; ++n) { const v4i iv = __builtin_bit_cast(v4i, acc[ai][bj][m][n]); acc[ai][bj][m][n] = (f32x4){(float)iv[0] * rs, (float)iv[1] * rs, (float)iv[2] * rs, (float)iv[3] * rs}; } }
}
__device__ __forceinline__ unsigned pk4_fp8(float a, float b, float c, float d) {
    a = __builtin_amdgcn_fmed3f(a, -448.0f, 448.0f); b = __builtin_amdgcn_fmed3f(b, -448.0f, 448.0f); c = __builtin_amdgcn_fmed3f(c, -448.0f, 448.0f); d = __builtin_amdgcn_fmed3f(d, -448.0f, 448.0f);
    int w = 0; w = __builtin_amdgcn_cvt_pk_fp8_f32(a, b, w, false); w = __builtin_amdgcn_cvt_pk_fp8_f32(c, d, w, true); return (unsigned)w; }

struct MergeOrder {
    StaticOrder so;
    __device__ void init(int G_, int c_) { so.init(16384, 2048, G_, c_); }
    __device__ bool next(int i, Unit& u) const { if (!so.next(i >> 1, u)) return false; if (i & 1) { u.pm += 64; u.pn += 8; } return true; }
    __device__ __forceinline__ void a_ready(const Unit&) const {}
    __device__ __forceinline__ void done(const Unit&) const {}
};
struct GroupedOrder {
    int NT, G, c, total; PG8_LAS int* tab;
    __device__ __forceinline__ void decode(int i, int& pm, int& pn) const {
        const int L = i * G + c; if (L >= total) { pm = -1; pn = 0; return; }
        int wgid = L; { const int q = total / NXCD, r = total % NXCD, xcd = wgid % NXCD, off = wgid / NXCD; wgid = (xcd < r ? xcd * (q + 1) : r * (q + 1) + (xcd - r) * q) + off; }
        int e = 0;
#pragma unroll
        for (int j = 1; j < 8; ++j) e += (wgid >= tab[j]) ? 1 : 0;
        const int base = tab[e], nM = tab[16 + e], r0 = tab[32 + e];
        const int idx = wgid - base, nig = WGM * NT, gid = idx / nig, fm = gid * WGM, gsz = (nM - fm) < WGM ? (nM - fm) : WGM, rem = idx % nig;
        pm = r0 + fm + rem % gsz; pn = e * NT + rem / gsz;
    }
    __device__ __forceinline__ void init(PG8_LAS int* tab_, const int* GT, int NT_, int G_, int c_) {
        NT = NT_; G = G_; c = c_; tab = tab_;
        __syncthreads();
        if (threadIdx.x == 0) { int up = 0; for (int e = 0; e < 8; ++e) { const int r = GT[e], n = GT[8 + e]; tab[e] = up; tab[16 + e] = n; tab[32 + e] = r; up += n * NT_; } tab[8] = up; }
        __syncthreads();
        total = __builtin_amdgcn_readfirstlane(tab[8]);
        if (threadIdx.x < 64) { int pm, pn; decode((int)threadIdx.x, pm, pn); tab[64 + 2 * threadIdx.x] = pm; tab[65 + 2 * threadIdx.x] = pn; }
        __syncthreads();
    }
    __device__ __forceinline__ bool next(int i, Unit& u) const {
        if (i >= 64) return false;
        const int pm = __builtin_amdgcn_readfirstlane(tab[64 + 2 * i]); if (pm < 0) return false;
        u.pm = pm; u.pn = __builtin_amdgcn_readfirstlane(tab[65 + 2 * i]); return true;
    }
    __device__ __forceinline__ void a_ready(const Unit&) const {}
    __device__ __forceinline__ void done(const Unit&) const {}
};

struct DownMainOrder {
    StaticOrder so; PG8_LAS int* tab;
    __device__ __forceinline__ void init(PG8_LAS int* tab_, int G_, int c_) { so.init(128 * BM, 8 * BM, G_, c_); tab = tab_; }
    __device__ __forceinline__ bool next(int i, Unit& u) const {
        if (!so.next(i, u)) return false;
        int e = 0;
#pragma unroll
        for (int j = 1; j < 8; ++j) e += (u.pm >= __builtin_amdgcn_readfirstlane(tab[32 + j])) ? 1 : 0;
        u.pn += e * 8; return true;
    }
    __device__ __forceinline__ void a_ready(const Unit&) const {}
    __device__ __forceinline__ void done(const Unit&) const {}
};
struct DownSpillOrder {
    int c, nunits; PG8_LAS int* tab;
    __device__ __forceinline__ void init(PG8_LAS int* tab_, int c_, int ntiles) { c = c_; nunits = (ntiles - 128) * 32; tab = tab_; }
    __device__ __forceinline__ bool next(int i, Unit& u) const {
        if (i != 0 || c >= nunits) return false;
        u.pm = 128 + (c >> 5); int e = 0;
#pragma unroll
        for (int j = 1; j < 8; ++j) e += (u.pm >= __builtin_amdgcn_readfirstlane(tab[32 + j])) ? 1 : 0;
        u.pn = e * 8 + ((c >> 2) & 7); return true;
    }
    __device__ __forceinline__ void a_ready(const Unit&) const {}
    __device__ __forceinline__ void done(const Unit&) const {}
};

struct EpiWin {
    static constexpr bool PERM = true, AFTER_DRAIN = false;
    bf16_t *Q, *K, *V, *BC, *U, *R, *GC; const float *qn, *kn; const float* rowscale; float wsc;
    __device__ __forceinline__ bool zero_after(const Unit&) const { return true; }
    __device__ __forceinline__ void operator()(f32x4 (&acc)[2][2][4][2], const Unit& u, int wr, int wc, int fr, int fq) const {
        const int pn = u.pn; const size_t row0 = (size_t)u.pm * BM + wr * 64 + fr;
        acc_i32_to_f32(acc, rowscale, row0, wsc);
        if (pn < 5) {
            const bool isq = pn < 4; const float* gn = isq ? qn : kn; const float osc = isq ? QSCALE : 1.0f;
            bf16_t* dst = isq ? Q : K; const int ld = isq ? DATT : DKV; const int hcol = (isq ? pn * 4 + wc : wc) * 64 + 8 * fq;
            f32x4 g[2][2];
#pragma unroll
            for (int bj = 0; bj < 2; ++bj)
#pragma unroll
                for (int n = 0; n < 2; ++n) g[bj][n] = *(const f32x4*)(gn + 32 * bj + 8 * fq + 4 * n) * osc;
#pragma unroll
            for (int ai = 0; ai < 2; ++ai)
#pragma unroll
                for (int m = 0; m < 4; ++m) {
                    float ss = 0.f;
#pragma unroll
                    for (int bj = 0; bj < 2; ++bj)
#pragma unroll
                        for (int n = 0; n < 2; ++n) { const f32x4 x = acc[ai][bj][m][n]; ss += (x[0] * x[0] + x[1] * x[1]) + (x[2] * x[2] + x[3] * x[3]); }
                    ss += __shfl_xor(ss, 16); ss += __shfl_xor(ss, 32);
                    const float rinv = 1.0f / sqrtf(ss * (1.0f / 64.0f) + EPS);
                    bf16_t* rowp = dst + (row0 + ai * HALF + m * 16) * ld + hcol;
#pragma unroll
                    for (int bj = 0; bj < 2; ++bj) *(u32x4*)(rowp + 32 * bj) = pack8(acc[ai][bj][m][0] * rinv * g[bj][0], acc[ai][bj][m][1] * rinv * g[bj][1]);
                }
        } else if (pn < 10) {
            const bool isv = pn == 5; bf16_t* dst = isv ? V : BC; const int ld = isv ? DKV : DCONV; const int col0 = (isv ? 0 : (pn - 6) * BM) + wc * 32 + 8 * fq;
#pragma unroll
            for (int ai = 0; ai < 2; ++ai)
#pragma unroll
                for (int m = 0; m < 4; ++m) { bf16_t* rowp = dst + (row0 + ai * HALF + m * 16) * ld + col0;
#pragma unroll
                    for (int bj = 0; bj < 2; ++bj) *(u32x4*)(rowp + bj * HALF) = pack8(acc[ai][bj][m][0], acc[ai][bj][m][1]); }
        } else if (pn < 18) {
            const int col0 = (pn - 10) * HALF + wc * 32 + 8 * fq;
#pragma unroll
            for (int ai = 0; ai < 2; ++ai)
#pragma unroll
                for (int m = 0; m < 4; ++m) *(u32x4*)(U + (row0 + ai * HALF + m * 16) * DCONV + col0) = pack8(acc[ai][0][m][0] * acc[ai][1][m][0], acc[ai][0][m][1] * acc[ai][1][m][1]);
        } else {
            const int col0 = (pn - 18) * HALF + wc * 32 + 8 * fq;
#pragma unroll
            for (int ai = 0; ai < 2; ++ai)
#pragma unroll
                for (int m = 0; m < 4; ++m) { f32x4 rr[2], sc[2];
#pragma unroll
                    for (int n = 0; n < 2; ++n)
#pragma unroll
                        for (int j = 0; j < 4; ++j) { const float ea = 1.0f + fast_exp(-acc[ai][0][m][n][j]); const float ec = 1.0f + fast_exp(-fmaxf(acc[ai][1][m][n][j], -30.0f));
                            const float ia = __builtin_amdgcn_rcpf(ea); rr[n][j] = ec * ia; sc[n][j] = __builtin_amdgcn_rcpf(ec); }
                    const size_t off = (row0 + ai * HALF + m * 16) * D + col0;
                    *(u32x4*)(R + off) = pack8(rr[0], rr[1]); *(u32x4*)(GC + off) = pack8(sc[0], sc[1]); }
        }
    }
};
struct EpiMerge {
    static constexpr bool PERM = true, AFTER_DRAIN = false;
    const bf16_t *R, *GC; bf16_t* MG;
    __device__ __forceinline__ bool zero_after(const Unit& u) const { return u.pm >= 64; }
    __device__ __forceinline__ void operator()(f32x4 (&acc)[2][2][4][2], const Unit& u, int wr, int wc, int fr, int fq) const {
        const bool second = u.pm >= 64; const int pm = u.pm & 63, pn = u.pn & 7;
        const size_t row0 = (size_t)pm * BM + wr * 64 + fr; const int col0 = pn * BM + wc * 32 + 8 * fq;
        const bf16_t* src = second ? GC : R;
#pragma unroll
        for (int ai = 0; ai < 2; ++ai)
#pragma unroll
            for (int m = 0; m < 4; ++m) { const size_t off = (row0 + ai * HALF + m * 16) * D + col0;
#pragma unroll
                for (int bj = 0; bj < 2; ++bj) { f32x4 a, b; unpack8(*(const u32x4*)(src + off + bj * HALF), a, b);
                    acc[ai][bj][m][0] *= a; acc[ai][bj][m][1] *= b;
                    if (second) *(u32x4*)(MG + off + bj * HALF) = pack8(acc[ai][bj][m][0], acc[ai][bj][m][1]); } }
    }
};
template <bool BASE_BF16>
struct EpiResid {
    static constexpr bool PERM = true, AFTER_DRAIN = false;
    const void* base; bf16_t* out; const float* gate;
    __device__ __forceinline__ bool zero_after(const Unit&) const { return true; }
    __device__ __forceinline__ void operator()(f32x4 (&acc)[2][2][4][2], const Unit& u, int wr, int wc, int fr, int fq) const {
        const size_t row0 = (size_t)u.pm * BM + wr * 64 + fr; const int col0 = u.pn * BM + wc * 32 + 8 * fq;
        const float* gp = gate + (size_t)(u.pm >> 4) * MODW + col0;
        f32x4 gv[2][2];
#pragma unroll
        for (int bj = 0; bj < 2; ++bj)
#pragma unroll
            for (int n = 0; n < 2; ++n) gv[bj][n] = *(const f32x4*)(gp + bj * HALF + n * 4);
#pragma unroll
        for (int ai = 0; ai < 2; ++ai)
#pragma unroll
            for (int m = 0; m < 4; ++m) { const size_t off = (row0 + ai * HALF + m * 16) * D + col0;
#pragma unroll
                for (int bj = 0; bj < 2; ++bj) { f32x4 b0, b1;
                    if (BASE_BF16) unpack8(*(const u32x4*)((const bf16_t*)base + off + bj * HALF), b0, b1);
                    else { b0 = *(const f32x4*)((const float*)base + off + bj * HALF); b1 = *(const f32x4*)((const float*)base + off + bj * HALF + 4); }
                    *(u32x4*)(out + off + bj * HALF) = pack8(b0 + gv[bj][0] * acc[ai][bj][m][0], b1 + gv[bj][1] * acc[ai][bj][m][1]); }
                if (m & 1) asm volatile("" ::: "memory"); }
    }
};
struct EpiSwiglu {
    static constexpr bool PERM = true, AFTER_DRAIN = false;
    bf16_t* O; int ld, NT;
    __device__ __forceinline__ bool zero_after(const Unit&) const { return true; }
    __device__ __forceinline__ void operator()(f32x4 (&acc)[2][2][4][2], const Unit& u, int wr, int wc, int fr, int fq) const {
        const size_t row0 = (size_t)u.pm * BM + wr * 64 + fr; const int col0 = (u.pn % NT) * HALF + wc * 32 + 8 * fq;
#pragma unroll
        for (int ai = 0; ai < 2; ++ai)
#pragma unroll
            for (int m = 0; m < 4; ++m) { f32x4 o[2];
#pragma unroll
                for (int n = 0; n < 2; ++n)
#pragma unroll
                    for (int j = 0; j < 4; ++j) { const float g = acc[ai][0][m][n][j]; o[n][j] = g * sigmoid_f(g) * acc[ai][1][m][n][j]; }
                *(u32x4*)(O + (row0 + ai * HALF + m * 16) * ld + col0) = pack8(o[0], o[1]); }
    }
};
struct EpiSwiglu8 {
    static constexpr bool PERM = true, AFTER_DRAIN = false;
    unsigned char* O; int ld, NT; const float* rowscale; float wsc;
    __device__ __forceinline__ bool zero_after(const Unit&) const { return true; }
    __device__ __forceinline__ void operator()(f32x4 (&acc)[2][2][4][2], const Unit& u, int wr, int wc, int fr, int fq) const {
        const size_t row0 = (size_t)u.pm * BM + wr * 64 + fr; const int col0 = (u.pn % NT) * HALF + wc * 32 + 8 * fq;
        acc_i32_to_f32(acc, rowscale, row0, wsc);
#pragma unroll
        for (int ai = 0; ai < 2; ++ai)
#pragma unroll
            for (int m = 0; m < 4; ++m) { f32x4 o[2];
#pragma unroll
                for (int n = 0; n < 2; ++n)
#pragma unroll
                    for (int j = 0; j < 4; ++j) { const float g = acc[ai][0][m][n][j]; o[n][j] = g * sigmoid_f(g) * acc[ai][1][m][n][j] * ACT8_SCALE; }
                typedef unsigned u32x2 __attribute__((ext_vector_type(2)));
                u32x2 w; w.x = pk4_fp8(o[0][0], o[0][1], o[0][2], o[0][3]); w.y = pk4_fp8(o[1][0], o[1][1], o[1][2], o[1][3]);
                *(u32x2*)(O + (row0 + ai * HALF + m * 16) * ld + col0) = w; }
    }
};
struct EpiY {
    static constexpr bool PERM = true, AFTER_DRAIN = false;
    bf16_t* Y; int pm0;
    __device__ __forceinline__ bool zero_after(const Unit&) const { return true; }
    __device__ __forceinline__ void operator()(f32x4 (&acc)[2][2][4][2], const Unit& u, int wr, int wc, int fr, int fq) const {
        const size_t row0 = (size_t)(u.pm - pm0) * BM + wr * 64 + fr; const int col0 = (u.pn & 7) * BM + wc * 32 + 8 * fq;
#pragma unroll
        for (int ai = 0; ai < 2; ++ai)
#pragma unroll
            for (int m = 0; m < 4; ++m) { bf16_t* rowp = Y + (row0 + ai * HALF + m * 16) * D + col0;
#pragma unroll
                for (int bj = 0; bj < 2; ++bj) *(u32x4*)(rowp + bj * HALF) = pack8(acc[ai][bj][m][0], acc[ai][bj][m][1]); }
    }
};

template <class Epi, class Sched, bool ALIGN_EPI = false, bool SP2 = false, int MODE = 0  >
__device__ __forceinline__ void gemm_phase(PG8_LAS unsigned char* lds, const Gemm g, const Sched& S, const Epi& E) {
    constexpr bool FP8 = (MODE == 1), I8 = (MODE == 2);
    const int tid = threadIdx.x, wid = __builtin_amdgcn_readfirstlane(tid >> 6), lane = tid & 63, wr = wid >> 2, wc = wid & 3, fr = lane & 15, fq = lane >> 4;
    const int K = g.K, nt = (g.Kloop ? g.Kloop : K) / BK;
    unsigned voffA[2], voffB[2];
#pragma unroll
    for (int i = 0; i < 2; ++i) { int R, C; stage_rc(tid * 16 + i * 8192, R, C); const int Rb = Epi::PERM ? ((R & ~31) + perm32(R & 31)) : R;
        voffA[i] = (unsigned)(R * K + C) * 2u; voffB[i] = (unsigned)(Rb * K + C) * 2u; }
    const size_t kstep = (size_t)(BK * 2);
    const size_t hstep = (size_t)HALF * K * 2;
    const size_t tstep = 2 * hstep;
    const unsigned ldsw = (unsigned)wid * 1024u;
    const int aoff = lds_byte(wr * 64 + fr, fq * 8), boff = lds_byte(wc * 32 + fr, fq * 8);
#define PG8_SA(b, h) (((b) * 2 + (h)) * HTB)
#define PG8_SB(b, h) ((4 + (b) * 2 + (h)) * HTB)
#define PG8_STAGE(bufoff, gbase, voff) do { _Pragma("unroll") for (int _i = 0; _i < 2; ++_i) \
        __builtin_amdgcn_global_load_lds((const unsigned*)((const char*)(gbase) + (voff)[_i]), (PG8_LAS unsigned*)(lds + (bufoff) + ldsw + _i * 8192), 16, 0, 0); } while (0)
#define PG8_LDA(dst, b, h) do { _Pragma("unroll") for (int m = 0; m < 4; ++m) { if constexpr (FP8) dst##8[m] = __builtin_shufflevector(*(const PG8_LAS v4i*)(lds + PG8_SA(b, h) + aoff + m * 2048), *(const PG8_LAS v4i*)(lds + PG8_SA(b, h) + aoff + m * 2048 + 1024), 0, 1, 2, 3, 4, 5, 6, 7); \
        else { _Pragma("unroll") for (int k = 0; k < 2; ++k) dst[m][k] = *(const PG8_LAS bf16x8*)(lds + PG8_SA(b, h) + aoff + m * 2048 + k * 1024); } } } while (0)
#define PG8_LDB(dst, b, h) do { _Pragma("unroll") for (int n = 0; n < 2; ++n) { if constexpr (FP8) dst##8[n] = __builtin_shufflevector(*(const PG8_LAS v4i*)(lds + PG8_SB(b, h) + boff + n * 2048), *(const PG8_LAS v4i*)(lds + PG8_SB(b, h) + boff + n * 2048 + 1024), 0, 1, 2, 3, 4, 5, 6, 7); \
        else { _Pragma("unroll") for (int k = 0; k < 2; ++k) dst[n][k] = *(const PG8_LAS bf16x8*)(lds + PG8_SB(b, h) + boff + n * 2048 + k * 1024); } } } while (0)
#define PG8_MMA(ai, bj, At, Bt) do { __builtin_amdgcn_s_setprio(1); \
        if constexpr (FP8) { _Pragma("unroll") for (int m = 0; m < 4; ++m) _Pragma("unroll") for (int n = 0; n < 2; ++n) \
            asm volatile("v_mfma_scale_f32_16x16x128_f8f6f4 %0, %1, %2, %0, %3, %4 op_sel:[0,0,0] op_sel_hi:[0,0,0]" : "+v"(acc[ai][bj][m][n]) : "v"(Bt##8[n]), "v"(At##8[m]), "v"(scaleB8), "v"(scaleA8)); } \
        else if constexpr (I8) { _Pragma("unroll") for (int m = 0; m < 4; ++m) _Pragma("unroll") for (int n = 0; n < 2; ++n) _Pragma("unroll") for (int k = 0; k < 2; ++k) \
            acc[ai][bj][m][n] = __builtin_bit_cast(f32x4, __builtin_amdgcn_mfma_i32_16x16x64_i8(__builtin_bit_cast(v4i, Bt[n][k]), __builtin_bit_cast(v4i, At[m][k]), __builtin_bit_cast(v4i, acc[ai][bj][m][n]), 0, 0, 0)); } \
        else { _Pragma("unroll") for (int m = 0; m < 4; ++m) _Pragma("unroll") for (int n = 0; n < 2; ++n) _Pragma("unroll") for (int k = 0; k < 2; ++k) \
            acc[ai][bj][m][n] = __builtin_amdgcn_mfma_f32_16x16x32_bf16(Bt[n][k], At[m][k], acc[ai][bj][m][n], 0, 0, 0); } \
        __builtin_amdgcn_s_setprio(0); } while (0)
#define PG8_WAIT_V(n) asm volatile("s_waitcnt vmcnt(" #n ")" ::: "memory")
#define PG8_WAIT_L(n) asm volatile("s_waitcnt lgkmcnt(" #n ")" ::: "memory")
#define PG8_BAR __builtin_amdgcn_s_barrier()
#define PG8_SCHED __builtin_amdgcn_sched_barrier(0)
    Unit cur, nxt; int ui = 0;
    if (!S.next(0, cur)) return;
    f32x4 acc[2][2][4][2];
#pragma unroll
    for (int a = 0; a < 2; ++a)
#pragma unroll
        for (int b = 0; b < 2; ++b)
#pragma unroll
            for (int m = 0; m < 4; ++m)
#pragma unroll
                for (int n = 0; n < 2; ++n) acc[a][b][m][n] = (f32x4){0.f, 0.f, 0.f, 0.f};
    const int scaleB8 = (g.sB & 0xff) * 0x01010101, scaleA8 = ((g.sB >> 8) & 0xff) * 0x01010101;
    bf16x8 At[4][2], B0[2][2], B1[2][2]; v8i At8[4], B08[2], B18[2];
    const char* cA = (const char*)g.A + (size_t)cur.pm * tstep; const char* cB = (const char*)g.Bt + (size_t)cur.pn * tstep;
    S.a_ready(cur);
    if constexpr (SP2) {
        PG8_STAGE(PG8_SB(0, 0), cB, voffB); PG8_STAGE(PG8_SB(0, 1), cB + hstep, voffB); PG8_STAGE(PG8_SA(0, 0), cA, voffA); PG8_STAGE(PG8_SA(0, 1), cA + hstep, voffA);
        if (wr == 1) PG8_BAR;
        PG8_WAIT_V(2); PG8_BAR;
        PG8_STAGE(PG8_SB(1, 0), cB + kstep, voffB); PG8_STAGE(PG8_SA(1, 0), cA + kstep, voffA); PG8_STAGE(PG8_SB(1, 1), cB + hstep + kstep, voffB);
        PG8_WAIT_V(6); PG8_BAR;
    } else {
        PG8_STAGE(PG8_SB(0, 0), cB, voffB); PG8_STAGE(PG8_SA(0, 0), cA, voffA); PG8_STAGE(PG8_SB(0, 1), cB + hstep, voffB); PG8_STAGE(PG8_SA(0, 1), cA + hstep, voffA);
        if (wr == 1) PG8_BAR;
        PG8_WAIT_V(4); PG8_BAR;
        PG8_STAGE(PG8_SB(1, 0), cB + kstep, voffB); PG8_STAGE(PG8_SA(1, 0), cA + kstep, voffA); PG8_STAGE(PG8_SB(1, 1), cB + hstep + kstep, voffB);
        PG8_WAIT_V(6); PG8_BAR;
    }
    for (;;) {
        const bool has_next = S.next(ui + 1, nxt);
        const char* nA = has_next ? (const char*)g.A + (size_t)nxt.pm * tstep : cA; const char* nB = has_next ? (const char*)g.Bt + (size_t)nxt.pn * tstep : cB;
        for (int t = 0; t < nt; t += 2) {
            const bool last = (t == nt - 2);
            const char* a1 = cA + (size_t)(t + 1) * kstep;
            const char* a2 = last ? nA : cA + (size_t)(t + 2) * kstep; const char* b2 = last ? nB : cB + (size_t)(t + 2) * kstep;
            const char* a3 = a2 + kstep; const char* b3 = b2 + kstep;
            if (last && has_next) S.a_ready(nxt);
            if constexpr (SP2) {
            PG8_LDB(B0, 0, 0); PG8_LDB(B1, 0, 1); PG8_SCHED; PG8_LDA(At, 0, 0); PG8_STAGE(PG8_SA(1, 1), a1 + hstep, voffA);
            PG8_WAIT_V(8); PG8_WAIT_L(0); PG8_BAR; PG8_MMA(0, 0, At, B0); PG8_MMA(0, 1, At, B1); PG8_BAR; PG8_SCHED;
            PG8_LDA(At, 0, 1); PG8_STAGE(PG8_SB(0, 0), b2, voffB); PG8_STAGE(PG8_SB(0, 1), b2 + hstep, voffB); PG8_STAGE(PG8_SA(0, 0), a2, voffA);
            PG8_WAIT_V(8); PG8_WAIT_L(0); PG8_BAR; PG8_MMA(1, 0, At, B0); PG8_MMA(1, 1, At, B1); PG8_BAR; PG8_SCHED;
            PG8_LDB(B0, 1, 0); PG8_LDB(B1, 1, 1); PG8_SCHED; PG8_LDA(At, 1, 0); PG8_STAGE(PG8_SA(0, 1), a2 + hstep, voffA);
            PG8_WAIT_V(8); PG8_WAIT_L(0); PG8_BAR; PG8_MMA(0, 0, At, B0); PG8_MMA(0, 1, At, B1); PG8_BAR; PG8_SCHED;
            PG8_LDA(At, 1, 1); PG8_STAGE(PG8_SB(1, 0), b3, voffB); PG8_STAGE(PG8_SB(1, 1), b3 + hstep, voffB); PG8_STAGE(PG8_SA(1, 0), a3, voffA);
            PG8_WAIT_V(8); PG8_WAIT_L(0); PG8_BAR; PG8_MMA(1, 0, At, B0); PG8_MMA(1, 1, At, B1); PG8_BAR; PG8_SCHED;
            } else {
            PG8_LDB(B0, 0, 0); PG8_SCHED; PG8_LDA(At, 0, 0); PG8_STAGE(PG8_SA(1, 1), a1 + hstep, voffA);
            PG8_WAIT_L(8); PG8_BAR; PG8_WAIT_L(0); PG8_MMA(0, 0, At, B0); PG8_BAR; PG8_SCHED;
            PG8_LDB(B1, 0, 1); PG8_STAGE(PG8_SB(0, 0), b2, voffB);
            PG8_BAR; PG8_WAIT_L(0); PG8_MMA(0, 1, At, B1); PG8_BAR;
            PG8_LDA(At, 0, 1); PG8_STAGE(PG8_SA(0, 0), a2, voffA);
            PG8_BAR; PG8_WAIT_L(0); PG8_MMA(1, 0, At, B0); PG8_BAR; PG8_SCHED;
            PG8_STAGE(PG8_SB(0, 1), b2 + hstep, voffB);
            PG8_WAIT_V(6); PG8_BAR; PG8_MMA(1, 1, At, B1); PG8_BAR;
            PG8_LDB(B0, 1, 0); PG8_SCHED; PG8_LDA(At, 1, 0); PG8_STAGE(PG8_SA(0, 1), a2 + hstep, voffA);
            PG8_WAIT_L(8); PG8_BAR; PG8_WAIT_L(0); PG8_MMA(0, 0, At, B0); PG8_BAR; PG8_SCHED;
            PG8_LDB(B1, 1, 1); PG8_STAGE(PG8_SB(1, 0), b3, voffB);
            PG8_BAR; PG8_WAIT_L(0); PG8_MMA(0, 1, At, B1); PG8_BAR;
            PG8_LDA(At, 1, 1); PG8_STAGE(PG8_SA(1, 0), a3, voffA);
            PG8_BAR; PG8_WAIT_L(0); PG8_MMA(1, 0, At, B0); PG8_BAR; PG8_SCHED;
            PG8_STAGE(PG8_SB(1, 1), b3 + hstep, voffB);
            PG8_WAIT_V(6); PG8_BAR; PG8_MMA(1, 1, At, B1); PG8_BAR;
            }
        }
        if constexpr (FP8) asm volatile("s_nop 15\n\ts_nop 15" ::: "memory");
        if constexpr (ALIGN_EPI) { if (wr == 0) PG8_BAR; }
        if constexpr (!Epi::AFTER_DRAIN) { E(acc, cur, wr, wc, fr, fq); S.done(cur); }
        if (!has_next) break;
        if (E.zero_after(cur)) {
#pragma unroll
        for (int a = 0; a < 2; ++a)
#pragma unroll
            for (int b = 0; b < 2; ++b)
#pragma unroll
                for (int m = 0; m < 4; ++m)
#pragma unroll
                    for (int n = 0; n < 2; ++n) acc[a][b][m][n] = (f32x4){0.f, 0.f, 0.f, 0.f}; }
        cur = nxt; cA = nA; cB = nB; ++ui;
        if constexpr (ALIGN_EPI) { if (wr == 1) PG8_BAR; }
    }
    PG8_WAIT_V(0);
    if constexpr (!ALIGN_EPI) { if (wr == 0) PG8_BAR; }
    PG8_BAR;
    if constexpr (Epi::AFTER_DRAIN) { E.fused(acc, cur, wr, wc, fr, fq, lds, wid, lane); S.done(cur); }
#undef PG8_SA
#undef PG8_SB
#undef PG8_STAGE
#undef PG8_LDA
#undef PG8_LDB
#undef PG8_MMA
#undef PG8_WAIT_V
#undef PG8_WAIT_L
#undef PG8_BAR
#undef PG8_SCHED
}
}
#define XB_TMO      128
#define XB_XCNT(j)  (256  + 64 * (j))
#define XB_XSUB(j)  (1280 + 64 * (j))
#define XB_XGEN(j)  (2304 + 64 * (j))
#define XB_TOP      3328
#define XB_TOPGEN   3392
#define XCD_BAR_WORDS 3456
#define XB_SPIN_CAP (1u << 18)

__device__ __forceinline__ unsigned xb_ld(unsigned* p)              { return __hip_atomic_load(p, __ATOMIC_RELAXED, __HIP_MEMORY_SCOPE_AGENT); }
__device__ __forceinline__ unsigned xb_add(unsigned* p, unsigned v) { return __hip_atomic_fetch_add(p, v, __ATOMIC_RELAXED, __HIP_MEMORY_SCOPE_AGENT); }
__device__ __forceinline__ unsigned xb_xcc_id() { return (unsigned)__builtin_amdgcn_s_getreg((3 << 11) | 20) & 0xFu; }
#define XB_SPIN(cond, bar) do { unsigned _sp = 0; while (cond) { __builtin_amdgcn_s_sleep(1); \
    if ((++_sp & 255u) == 0u) { if (xb_ld(&(bar)[XB_TMO])) break; if (_sp > XB_SPIN_CAP) { atomicAdd(&(bar)[XB_TMO], 1u); break; } } } } while (0)

struct XcdBarrier {
    unsigned* bar; unsigned x;
    volatile LAS unsigned* st;
};

__device__ __forceinline__ XcdBarrier xcd_barrier_post(unsigned* bar, volatile LAS unsigned* st) {
    XcdBarrier b; b.bar = bar; b.x = xb_xcc_id(); b.st = st;
    if (threadIdx.x == 0) (void)xb_add(&bar[XB_XCNT(b.x)], 1u);
    return b;
}
__device__ __forceinline__ void xcd_barrier_complete(unsigned* bar, unsigned x, unsigned& nloc, unsigned& nx) {
    const unsigned G = gridDim.x * gridDim.y * gridDim.z;
    unsigned sum, cnt, mine, sp = 0u;
    for (;;) {
        sum = 0u; cnt = 0u; mine = 0u;
#pragma unroll
        for (unsigned j = 0; j < 16; ++j) { const unsigned c = xb_ld(&bar[XB_XCNT(j)]); sum += c; cnt += (c > 0u) ? 1u : 0u; mine = (j == x) ? c : mine; }
        if (sum == G) break;
        __builtin_amdgcn_s_sleep(1);
        if ((++sp & 255u) == 0u) { if (xb_ld(&bar[XB_TMO])) break; if (sp > XB_SPIN_CAP) { atomicAdd(&bar[XB_TMO], 1u); break; } }
    }
    nloc = mine > 0u ? mine : 1u; nx = cnt > 0u ? cnt : 1u;
}

__device__ __forceinline__ void xcd_barrier(const XcdBarrier& b) {
    asm volatile("s_waitcnt vmcnt(0)" ::: "memory");
    __syncthreads();
    if (threadIdx.x == 0) {
        unsigned* bar = b.bar;
        __builtin_amdgcn_s_waitcnt(0);
        unsigned nloc = b.st[0], nx = b.st[1];
        if (nloc == 0u) { xcd_barrier_complete(bar, b.x, nloc, nx); b.st[0] = nloc; b.st[1] = nx; }
        const unsigned old = xb_add(&bar[XB_XSUB(b.x)], 1u);
        const unsigned gen = old / nloc;
        if (old + 1u == (gen + 1u) * nloc) {
            __builtin_amdgcn_fence(__ATOMIC_RELEASE, "agent");
            asm volatile("s_waitcnt vmcnt(0)" ::: "memory");
            const unsigned og = xb_add(&bar[XB_TOP], 1u);
            const unsigned tg = og / nx;
            if (og + 1u == (tg + 1u) * nx) xb_add(&bar[XB_TOPGEN], 1u);
            else XB_SPIN(xb_ld(&bar[XB_TOPGEN]) == tg, bar);
            __builtin_amdgcn_fence(__ATOMIC_ACQUIRE, "agent");
            xb_add(&bar[XB_XGEN(b.x)], 1u);
            asm volatile("s_waitcnt vmcnt(0)" ::: "memory");
        } else {
            XB_SPIN(xb_ld(&bar[XB_XGEN(b.x)]) == gen, bar);
            __builtin_amdgcn_fence(__ATOMIC_ACQUIRE, "agent");
            asm volatile("s_waitcnt vmcnt(0)" ::: "memory");
        }
    }
    __syncthreads();
}

typedef pg8::bf16_t bf16_t;
typedef pg8::f32x4 f32x4;
typedef pg8::bf16x8 bf16x8;
__device__ __forceinline__ unsigned f2bf(float f) { unsigned u = __builtin_bit_cast(unsigned, f); return (u + 0x7fffu + ((u >> 16) & 1u)) >> 16; }
__device__ __forceinline__ unsigned pk2(float lo, float hi) { return f2bf(lo) | (f2bf(hi) << 16); }
__device__ __forceinline__ float wave_sum(float v) {
#pragma unroll
    for (int o = 1; o < 64; o <<= 1) v += __shfl_xor(v, o);
    return v;
}
__device__ __forceinline__ void lds_add(LAS int* p, int v) { (void)__hip_atomic_fetch_add(p, v, __ATOMIC_RELAXED, __HIP_MEMORY_SCOPE_WORKGROUP); }
__device__ __forceinline__ float bf_lo(unsigned w) { return __uint_as_float(w << 16); }
__device__ __forceinline__ float bf_hi(unsigned w) { return __uint_as_float(w & 0xffff0000u); }

__device__ __forceinline__ void p0_mod(LAS unsigned char* lds, const float* cvec, const float* ada_w, const float* ada_b, float* MOD, int G) {
    LAS float* sc = (LAS float*)lds;
    LAS float* red = (LAS float*)(lds + 32768);
    const int tid = threadIdx.x, lane = tid & 63, wave = tid >> 6;
    for (int i = tid; i < NBATCH * D; i += 512) { const float v = cvec[i]; sc[i] = v / (1.0f + __expf(-v)); }
    __syncthreads();
    for (int it = blockIdx.x; it < 2 * (MODW / 32); it += G) {
        const int l = it / (MODW / 32), n0 = (it % (MODW / 32)) * 32, kp = lane >> 3, cq = lane & 7;
        const GAS f32x4* W = (const GAS f32x4*)(ada_w + (size_t)l * D * MODW + n0 + 4 * cq);
        f32x4 a0 = {0.f, 0.f, 0.f, 0.f}, a1 = a0, a2 = a0, a3 = a0;
        const int k0 = wave * 256 + kp;
        for (int kk = k0; kk < k0 + 256; kk += 128) {
            f32x4 w[16];
#pragma unroll
            for (int u = 0; u < 16; ++u) w[u] = W[(size_t)(kk + 8 * u) * (MODW / 4)];
#pragma unroll
            for (int u = 0; u < 16; ++u) { const int k = kk + 8 * u; a0 += w[u] * sc[k]; a1 += w[u] * sc[D + k]; a2 += w[u] * sc[2 * D + k]; a3 += w[u] * sc[3 * D + k]; }
        }
#pragma unroll
        for (int o = 8; o < 64; o <<= 1) {
#pragma unroll
            for (int c = 0; c < 4; ++c) { a0[c] += __shfl_xor(a0[c], o); a1[c] += __shfl_xor(a1[c], o); a2[c] += __shfl_xor(a2[c], o); a3[c] += __shfl_xor(a3[c], o); } }
        if (lane < 8) { *(LAS f32x4*)(red + (wave * 4 + 0) * 32 + 4 * lane) = a0; *(LAS f32x4*)(red + (wave * 4 + 1) * 32 + 4 * lane) = a1; *(LAS f32x4*)(red + (wave * 4 + 2) * 32 + 4 * lane) = a2; *(LAS f32x4*)(red + (wave * 4 + 3) * 32 + 4 * lane) = a3; }
        __syncthreads();
        if (wave < 4 && lane < 32) { float s = 0.f;
#pragma unroll
            for (int w2 = 0; w2 < 8; ++w2) s += red[(w2 * 4 + wave) * 32 + lane];
            MOD[(size_t)(l * NBATCH + wave) * MODW + n0 + lane] = s + ada_b[l * MODW + n0 + lane]; }
        __syncthreads();
    }
}
__device__ __forceinline__ int win_src_col(int dg) {
    const int pn = dg >> 3, wi = dg & 7;
    if (pn < 5) return 256 * pn + 64 * (wi & 3) + 32 * (wi >> 2);
    if (pn < 10) return 32 * dg;
    if (pn < 18) return 2560 + (wi >> 2) * 1024 + (pn - 10) * 128 + (wi & 3) * 32;
    return 4608 + (wi >> 2) * 2048 + (pn - 18) * 128 + (wi & 3) * 32;
}
__device__ __forceinline__ int gu_src_col(int dg, int F) { const int pn = dg >> 3, wi = dg & 7; return (wi >> 2) * F + pn * 128 + (wi & 3) * 32; }

struct Wts { const float *w_in, *w_ab, *w_cb, *w_out, *ffn_gu, *ffn_dn, *moe_gu, *moe_dn; bf16_t *WAC, *WOUT; unsigned char *WIN, *WGU, *WDN, *MGU, *MDN; };
struct TrDesc { const float* src; unsigned char* dst; int N, pitch, mode; float scale; };
__device__ __forceinline__ TrDesc tr_decode(const Wts& w, int it) {
    constexpr int I_WIN = (D / 64) * (DIN / 32), I_AC = (DATT / 64) * (D / 32), I_OUT = (D / 64) * (D / 32), I_GU = (D / 64) * (2 * DFF / 32), I_DN = (DFF / 64) * (D / 32),
                  I_MGU = (D / 64) * (2 * MFF / 32), I_MDN = (MFF / 64) * (D / 32);
    TrDesc d; int r = it;
    if (r < 2 * I_WIN) { const int l = r / I_WIN, rr = r % I_WIN, kb = rr % (D / 64), dg = rr / (D / 64);
        d.src = w.w_in + (size_t)l * D * DIN + (size_t)(64 * kb) * DIN + win_src_col(dg); d.N = DIN; d.pitch = D; d.mode = 2; d.scale = W8I_SCALE; d.dst = w.WIN + (size_t)l * DIN * D + (size_t)(32 * dg) * D + 64 * kb; return d; }
    r -= 2 * I_WIN;
    if (r < 4 * I_AC) { const int mi = r / I_AC, rr = r % I_AC, l = mi >> 1, which = mi & 1, kb = rr % (DATT / 64), dg = rr / (DATT / 64);
        d.src = (which ? w.w_cb : w.w_ab) + (size_t)l * DATT * D + (size_t)(64 * kb) * D + 32 * dg; d.N = D; d.pitch = DATT * 2; d.mode = 0; d.scale = 1.0f; d.dst = (unsigned char*)(w.WAC + (size_t)mi * D * DATT + (size_t)(32 * dg) * DATT + 64 * kb); return d; }
    r -= 4 * I_AC;
    if (r < 2 * I_OUT) { const int l = r / I_OUT, rr = r % I_OUT, kb = rr % (D / 64), dg = rr / (D / 64);
        d.src = w.w_out + (size_t)l * D * D + (size_t)(64 * kb) * D + 32 * dg; d.N = D; d.pitch = D * 2; d.mode = 0; d.scale = 1.0f; d.dst = (unsigned char*)(w.WOUT + (size_t)l * D * D + (size_t)(32 * dg) * D + 64 * kb); return d; }
    r -= 2 * I_OUT;
    if (r < I_GU) { const int kb = r % (D / 64), dg = r / (D / 64);
        d.src = w.ffn_gu + (size_t)(64 * kb) * (2 * DFF) + gu_src_col(dg, DFF); d.N = 2 * DFF; d.pitch = D; d.mode = 2; d.scale = W8I_SCALE; d.dst = w.WGU + (size_t)(32 * dg) * D + 64 * kb; return d; }
    r -= I_GU;
    if (r < I_DN) { const int kb = r % (DFF / 64), dg = r / (DFF / 64);
        d.src = w.ffn_dn + (size_t)(64 * kb) * D + 32 * dg; d.N = D; d.pitch = DFF; d.mode = 1; d.scale = (float)(1 << MDN8_LOG2); d.dst = w.WDN + (size_t)(32 * dg) * DFF + 64 * kb; return d; }
    r -= I_DN;
    if (r < NEXP * I_MGU) { const int e = r / I_MGU, rr = r % I_MGU, kb = rr % (D / 64), dg = rr / (D / 64);
        d.src = w.moe_gu + (size_t)e * D * 2 * MFF + (size_t)(64 * kb) * (2 * MFF) + gu_src_col(dg, MFF); d.N = 2 * MFF; d.pitch = D; d.mode = 2; d.scale = W8I_SCALE; d.dst = w.MGU + (size_t)e * 2 * MFF * D + (size_t)(32 * dg) * D + 64 * kb; return d; }
    r -= NEXP * I_MGU;
    { const int e = r / I_MDN, rr = r % I_MDN, kb = rr % (MFF / 64), dg = rr / (MFF / 64);
        d.src = w.moe_dn + (size_t)e * MFF * D + (size_t)(64 * kb) * D + 32 * dg; d.N = D; d.pitch = MFF; d.mode = 1; d.scale = (float)(1 << MDN8_LOG2); d.dst = w.MDN + (size_t)e * D * MFF + (size_t)(32 * dg) * MFF + 64 * kb; return d; }
}
__device__ __forceinline__ void tr_load(const TrDesc& d, int lane, f32x4 (&a)[8]) {
    const GAS f32x4* src = (const GAS f32x4*)(d.src + (size_t)(8 * (lane >> 3)) * d.N + 4 * (lane & 7));
#pragma unroll
    for (int i = 0; i < 8; ++i) a[i] = src[(size_t)i * (d.N / 4)];
}
__device__ __forceinline__ void tr_store(const TrDesc& d, int lane, const f32x4 (&a)[8]) {
    const int kb = lane >> 3, nq = lane & 7;
#pragma unroll
    for (int c = 0; c < 4; ++c) {
        unsigned char* p = d.dst + (size_t)(4 * nq + c) * d.pitch;
        if (d.mode == 0) { v4u o; o.x = pk2(a[0][c], a[1][c]); o.y = pk2(a[2][c], a[3][c]); o.z = pk2(a[4][c], a[5][c]); o.w = pk2(a[6][c], a[7][c]); *(GAS v4u*)(p + 16 * kb) = o; }
        else { v2u o; const float sc = d.scale;
            if (d.mode == 2) { o.x = pg8::pk4_i8(a[0][c] * sc, a[1][c] * sc, a[2][c] * sc, a[3][c] * sc); o.y = pg8::pk4_i8(a[4][c] * sc, a[5][c] * sc, a[6][c] * sc, a[7][c] * sc); }
            else { o.x = pg8::pk4_fp8(a[0][c] * sc, a[1][c] * sc, a[2][c] * sc, a[3][c] * sc); o.y = pg8::pk4_fp8(a[4][c] * sc, a[5][c] * sc, a[6][c] * sc, a[7][c] * sc); }
            *(GAS v2u*)(p + 8 * kb) = o; }
    }
}
__device__ __forceinline__ void p0_convert(LAS unsigned char* lds, const Wts& w, int vcu, int G) {
    const int lane = threadIdx.x & 63, wave = threadIdx.x >> 6;
    const int gw = vcu * 8 + wave, NGW = G * 8;
    constexpr int NITEMS = 2 * (D / 64) * (DIN / 32) + 4 * (DATT / 64) * (D / 32) + 2 * (D / 64) * (D / 32);
    static_assert(NITEMS % 2 == 0, "items come in k-block pairs");
    int it = 2 * gw; if (it >= NITEMS) return;
    TrDesc p0 = tr_decode(w, it), p1 = tr_decode(w, it + 1), q0 = p0, q1 = p1; f32x4 a0[8], a1[8], b0[8], b1[8];
    tr_load(p0, lane, a0); tr_load(p1, lane, a1);
    for (;;) {
        it += 2 * NGW; const bool hq = it < NITEMS;
        if (hq) { q0 = tr_decode(w, it); q1 = tr_decode(w, it + 1); tr_load(q0, lane, b0); tr_load(q1, lane, b1); }
        tr_store(p0, lane, a0); tr_store(p1, lane, a1);
        if (!hq) break;
        it += 2 * NGW; const bool hp = it < NITEMS;
        if (hp) { p0 = tr_decode(w, it); p1 = tr_decode(w, it + 1); tr_load(p0, lane, a0); tr_load(p1, lane, a1); }
        tr_store(q0, lane, b0); tr_store(q1, lane, b1);
        if (!hp) break;
    }
}

struct TileDesc { const float* src; unsigned char* dst; int N, pitch, hstride, mode; float scale; };
__device__ __forceinline__ TileDesc tile_decode(const Wts& w, int t) {
    constexpr int T_GU = (D / 128) * (2 * DFF / 256), T_DN = (DFF / 128) * (D / 256), T_MGU = (D / 128) * (2 * MFF / 256), T_MDN = (MFF / 128) * (D / 256);
    TileDesc d; int r = t;
    if (r < T_GU) { const int kt = r % (D / 128), ct = r / (D / 128), col0 = 256 * ct, up = col0 >= DFF ? 1 : 0, j = (col0 - up * DFF) / 256;
        d.src = w.ffn_gu + (size_t)(128 * kt) * (2 * DFF) + col0; d.N = 2 * DFF; d.pitch = D; d.hstride = 256; d.mode = 2; d.scale = W8I_SCALE; d.dst = w.WGU + (size_t)(512 * j + 128 * up) * D + 128 * kt; return d; }
    r -= T_GU;
    if (r < T_DN) { const int kt = r % (DFF / 128), ct = r / (DFF / 128);
        d.src = w.ffn_dn + (size_t)(128 * kt) * D + 256 * ct; d.N = D; d.pitch = DFF; d.hstride = 128; d.mode = 1; d.scale = (float)(1 << MDN8_LOG2); d.dst = w.WDN + (size_t)(256 * ct) * DFF + 128 * kt; return d; }
    r -= T_DN;
    if (r < NEXP * T_MGU) { const int e = r / T_MGU, rr = r % T_MGU, kt = rr % (D / 128), ct = rr / (D / 128), col0 = 256 * ct, up = col0 >= MFF ? 1 : 0, j = (col0 - up * MFF) / 256;
        d.src = w.moe_gu + (size_t)e * D * 2 * MFF + (size_t)(128 * kt) * (2 * MFF) + col0; d.N = 2 * MFF; d.pitch = D; d.hstride = 256; d.mode = 2; d.scale = W8I_SCALE;
        d.dst = w.MGU + (size_t)e * 2 * MFF * D + (size_t)(512 * j + 128 * up) * D + 128 * kt; return d; }
    r -= NEXP * T_MGU;
    { const int e = r / T_MDN, rr = r % T_MDN, kt = rr % (MFF / 128), ct = rr / (MFF / 128);
        d.src = w.moe_dn + (size_t)e * MFF * D + (size_t)(128 * kt) * D + 256 * ct; d.N = D; d.pitch = MFF; d.hstride = 128; d.mode = 1; d.scale = (float)(1 << MDN8_LOG2);
        d.dst = w.MDN + (size_t)e * D * MFF + (size_t)(256 * ct) * MFF + 128 * kt; return d; }
}
__device__ __forceinline__ void tile_load(const TileDesc& d, int wave, int lane, f32x4 (&a)[16]) {
    const GAS f32x4* src = (const GAS f32x4*)(d.src + (size_t)(16 * wave) * d.N + 4 * lane);
#pragma unroll
    for (int i = 0; i < 16; ++i) a[i] = src[(size_t)i * (d.N / 4)];
}
__device__ __forceinline__ void tile_to_lds(const TileDesc& d, LAS unsigned char* buf, int wave, int lane, const f32x4 (&a)[16]) {
    const float sc = d.scale;
#pragma unroll
    for (int c = 0; c < 4; ++c) {
        v4u o;
        if (d.mode == 2) { o.x = pg8::pk4_i8(a[0][c] * sc, a[1][c] * sc, a[2][c] * sc, a[3][c] * sc); o.y = pg8::pk4_i8(a[4][c] * sc, a[5][c] * sc, a[6][c] * sc, a[7][c] * sc);
                           o.z = pg8::pk4_i8(a[8][c] * sc, a[9][c] * sc, a[10][c] * sc, a[11][c] * sc); o.w = pg8::pk4_i8(a[12][c] * sc, a[13][c] * sc, a[14][c] * sc, a[15][c] * sc); }
        else { o.x = pg8::pk4_fp8(a[0][c] * sc, a[1][c] * sc, a[2][c] * sc, a[3][c] * sc); o.y = pg8::pk4_fp8(a[4][c] * sc, a[5][c] * sc, a[6][c] * sc, a[7][c] * sc);
               o.z = pg8::pk4_fp8(a[8][c] * sc, a[9][c] * sc, a[10][c] * sc, a[11][c] * sc); o.w = pg8::pk4_fp8(a[12][c] * sc, a[13][c] * sc, a[14][c] * sc, a[15][c] * sc); }
        const int n = 4 * lane + c, pos = (((n & 1) << 3) + wave) ^ (lane & 15);
        *(LAS v4u*)(buf + (n >> 1) * 256 + 16 * pos) = o;
    }
}
__device__ __forceinline__ void tile_store(const TileDesc& d, const LAS unsigned char* buf, int tid) {
#pragma unroll
    for (int j = 0; j < 4; ++j) {
        const int row = j * 64 + (tid >> 3), ch = tid & 7, pos = (((row & 1) << 3) + ch) ^ ((row >> 2) & 15);
        const v4u v = *(const LAS v4u*)(buf + (row >> 1) * 256 + 16 * pos);
        *(GAS v4u*)(d.dst + (size_t)((row >> 7) * d.hstride + (row & 127)) * d.pitch + 16 * ch) = v;
    }
}
constexpr int NT_FFN = (D / 128) * (2 * DFF / 256) + (DFF / 128) * (D / 256), NQ_MOE = NEXP * ((D / 128) * (2 * MFF / 256) + (MFF / 128) * (D / 256));
__device__ __forceinline__ void p0_convert_tiles(LAS unsigned char* lds, const Wts& w, int vcu, int G) {
    constexpr int NT = NT_FFN;
    const int tid = threadIdx.x, lane = tid & 63, wave = __builtin_amdgcn_readfirstlane(tid >> 6);
    __syncthreads();
    int t = vcu; if (t >= NT) return;
    TileDesc p = tile_decode(w, t), q = p; f32x4 a[16], b[16];
    tile_load(p, wave, lane, a);
    for (;;) {
        t += G; const bool hq = t < NT;
        if (hq) { q = tile_decode(w, t); tile_load(q, wave, lane, b); }
        tile_to_lds(p, lds, wave, lane, a); __syncthreads(); tile_store(p, lds, tid);
        if (!hq) break;
        t += G; const bool hp = t < NT;
        if (hp) { p = tile_decode(w, t); tile_load(p, wave, lane, a); }
        tile_to_lds(q, lds + 32768, wave, lane, b); __syncthreads(); tile_store(q, lds + 32768, tid);
        if (!hp) break;
    }
    __syncthreads();
}

struct Args { const float* in[19]; float* out; unsigned char* ws; int ph_lo, ph_hi; };
constexpr int NQ_ALL = NT_FFN + NQ_MOE;
constexpr int NQ_GU_END = NT_FFN + NEXP * (D / 128) * (2 * MFF / 256);
constexpr int QMB_OFF = LDSCTL_OFF + 2560;
__device__ __forceinline__ TileDesc moe_tile_decode(const Args& args, int tq) {
    constexpr int T_GU = (D / 128) * (2 * DFF / 256), T_DN = (DFF / 128) * (D / 256), T_MGU = (D / 128) * (2 * MFF / 256);
    int r = tq, cls = 0;
    if (r >= T_GU) { r -= T_GU; cls = 1; if (r >= T_DN) { r -= T_DN; cls = 2; if (r >= NEXP * T_MGU) { r -= NEXP * T_MGU; cls = 3; } } }
    const bool isgu = (cls & 1) == 0; const int F = cls < 2 ? DFF : MFF;
    const int per = isgu ? (D / 128) * (2 * F / 256) : (F / 128) * (D / 256), nk = isgu ? D / 128 : F / 128;
    const int e = r / per, rr = r % per, kt = rr % nk, ct = rr / nk, col0 = 256 * ct, up = (isgu && col0 >= F) ? 1 : 0, j = (col0 - up * F) / 256;
    const size_t N = isgu ? 2 * F : D, pitch = isgu ? D : F, esz = isgu ? (size_t)D * 2 * F : (size_t)F * D;
    const GAS float* sb = (const GAS float*)(cls == 0 ? args.in[14] : cls == 1 ? args.in[15] : cls == 2 ? args.in[17] : args.in[18]);
    const size_t doff = cls == 0 ? WS_WGU : cls == 1 ? WS_WDN : cls == 2 ? WS_MGU : WS_MDN;
    GAS unsigned char* db = (GAS unsigned char*)args.ws + doff;
    TileDesc p;
    p.src = (const float*)(sb + (size_t)e * esz + (size_t)(128 * kt) * N + col0); p.N = (int)N; p.pitch = (int)pitch; p.hstride = isgu ? 256 : 128; p.mode = isgu ? 2 : 1;
    p.scale = isgu ? W8I_SCALE : (float)(1 << MDN8_LOG2);
    p.dst = (unsigned char*)(db + (size_t)e * esz + (isgu ? (size_t)(512 * j + 128 * up) * D : (size_t)(256 * ct) * F) + 128 * kt);
    return p;
}
__device__ __forceinline__ void convert_tiles(LAS unsigned char* lds, const Args& m, int tq, int n) {
    const int tid = threadIdx.x, lane = tid & 63, wave = __builtin_amdgcn_readfirstlane(tid >> 6);
    const TileDesc p = moe_tile_decode(m, tq); f32x4 a[16];
    tile_load(p, wave, lane, a);
    if (n == 2) {
        const TileDesc q = moe_tile_decode(m, tq + 1); f32x4 b2[16];
        tile_load(q, wave, lane, b2);
        tile_to_lds(p, lds, wave, lane, a); __syncthreads(); tile_store(p, lds, tid);
        tile_to_lds(q, lds + 32768, wave, lane, b2); __syncthreads(); tile_store(q, lds + 32768, tid); __syncthreads();
    } else { tile_to_lds(p, lds, wave, lane, a); __syncthreads(); tile_store(p, lds, tid); __syncthreads(); }
}
__device__ __forceinline__ void moe_tiles_rest(LAS unsigned char* lds, const Args& m, unsigned* qctr, unsigned limit) {
    volatile LAS unsigned* mb = (volatile LAS unsigned*)(lds + QMB_OFF);
    unsigned held = 0xffffffffu;
    for (;;) {
        __syncthreads();
        if (threadIdx.x == 0) { unsigned t = held; held = 0xffffffffu;
            if (t == 0xffffffffu && mb[3] == 0u && xb_ld(qctr) < limit) { t = xb_add(qctr, 2u); if (t >= (unsigned)NQ_ALL) { t = 0xffffffffu; mb[3] = 1u; } }
            mb[1] = t; }
        __syncthreads();
        const unsigned t = mb[1];
        if (t == 0xffffffffu) break;
        unsigned nx = 0xffffffffu;
        if (threadIdx.x == 0 && mb[3] == 0u && t + 2u < limit) nx = xb_add(qctr, 2u);
        convert_tiles(lds, m, (int)t, (t + 1u < (unsigned)NQ_ALL) ? 2 : 1);
        if (threadIdx.x == 0 && nx != 0xffffffffu) { if (nx >= (unsigned)NQ_ALL) mb[3] = 1u; else held = nx; }
    }
    __syncthreads();
}
__device__ __forceinline__ void xcd_barrier_work(const XcdBarrier& b, LAS unsigned char* lds, const Args& m, unsigned* qctr) {
    volatile LAS unsigned* mb = (volatile LAS unsigned*)(lds + QMB_OFF);
    asm volatile("s_waitcnt vmcnt(0)" ::: "memory");
    __syncthreads();
    unsigned gen = 0u;
    if (threadIdx.x == 0) {
        unsigned* bar = b.bar;
        __builtin_amdgcn_s_waitcnt(0);
        unsigned nloc = b.st[0], nx = b.st[1];
        if (nloc == 0u) { xcd_barrier_complete(bar, b.x, nloc, nx); b.st[0] = nloc; b.st[1] = nx; }
        const unsigned old = xb_add(&bar[XB_XSUB(b.x)], 1u);
        gen = old / nloc;
        if (old + 1u == (gen + 1u) * nloc) {
            __builtin_amdgcn_fence(__ATOMIC_RELEASE, "agent");
            asm volatile("s_waitcnt vmcnt(0)" ::: "memory");
            const unsigned og = xb_add(&bar[XB_TOP], 1u);
            const unsigned tg = og / nx;
            if (og + 1u == (tg + 1u) * nx) xb_add(&bar[XB_TOPGEN], 1u);
            else XB_SPIN(xb_ld(&bar[XB_TOPGEN]) == tg, bar);
            __builtin_amdgcn_fence(__ATOMIC_ACQUIRE, "agent");
            xb_add(&bar[XB_XGEN(b.x)], 1u);
            asm volatile("s_waitcnt vmcnt(0)" ::: "memory");
            mb[0] = 1u;
        } else if (mb[3] != 0u) {
            XB_SPIN(xb_ld(&bar[XB_XGEN(b.x)]) == gen, bar);
            __builtin_amdgcn_fence(__ATOMIC_ACQUIRE, "agent");
            asm volatile("s_waitcnt vmcnt(0)" ::: "memory");
            mb[0] = 1u;
        } else mb[0] = 0u;
    }
    __syncthreads();
    if (mb[0] == 0u) {
        unsigned sp = 0u;
        for (;;) {
            if (threadIdx.x == 0) {
                unsigned* bar = b.bar;
                const unsigned xg = xb_ld(&bar[XB_XGEN(b.x)]);
                unsigned done = (xg != gen) ? 1u : 0u, t = 0xffffffffu;
                if (!done) {
                    if (mb[3] == 0u) { t = xb_add(qctr, 2u); if (t >= (unsigned)NQ_ALL) { t = 0xffffffffu; mb[3] = 1u; } else mb[2] = (t + 2u <= (unsigned)NQ_ALL) ? 2u : 1u; }
                    if (t == 0xffffffffu) { __builtin_amdgcn_s_sleep(1); if ((++sp & 255u) == 0u) { if (xb_ld(&bar[XB_TMO])) done = 1u; else if (sp > XB_SPIN_CAP) { atomicAdd(&bar[XB_TMO], 1u); done = 1u; } } }
                }
                if (done) { __builtin_amdgcn_fence(__ATOMIC_ACQUIRE, "agent"); asm volatile("s_waitcnt vmcnt(0)" ::: "memory"); }
                mb[0] = done; mb[1] = t;
            }
            __syncthreads();
            const unsigned done = mb[0], t = mb[1], cnt = mb[2];
            __syncthreads();
            if (done) break;
            if (t != 0xffffffffu) convert_tiles(lds, m, (int)t, (int)cnt);
        }
    }
    __syncthreads();
}

template <bool MOE, bool XBF16>
__device__ __forceinline__ void norm_phase(LAS unsigned char* lds, const void* X, const float* gain, const float* scale, const float* shift, unsigned char* H, float* SA,
                                           const float* Wr, int* TOKE, float* TOKW, int* CNT, int G) {
    LAS float* tabA = (LAS float*)lds; LAS float* tabB = (LAS float*)(lds + 8192); LAS float* WrT = (LAS float*)(lds + 16384); LAS int* cnt = (LAS int*)(lds + 16384 + 65536);
    const int tid = threadIdx.x, lane = tid & 63, wave = tid >> 6;
    if (MOE) { for (int i = tid; i < D * NEXP; i += 512) WrT[(i & 7) * D + (i >> 3)] = Wr[i]; }
    for (int rb = blockIdx.x; rb < T / 64; rb += G) {
        const int b = rb >> 6;
        for (int i = tid; i < D; i += 512) { tabA[i] = gain[i] * (1.0f + scale[(size_t)b * MODW + i]); tabB[i] = shift[(size_t)b * MODW + i]; }
        if (MOE && tid < 8) cnt[tid] = 0;
        __syncthreads();
        v2u rawb[8]; f32x4 rawf[8];
        { const size_t r0 = (size_t)rb * 64 + wave * 8;
#pragma unroll
          for (int j = 0; j < 8; ++j) { if (XBF16) rawb[j] = ((const GAS v2u*)((const bf16_t*)X + r0 * D))[lane + 64 * j]; else rawf[j] = ((const GAS f32x4*)((const float*)X + r0 * D))[lane + 64 * j]; } }
        for (int i = 0; i < 8; ++i) {
            const size_t row = (size_t)rb * 64 + wave * 8 + i;
            const size_t rnx = row + 1 < (size_t)T ? row + 1 : row;
            f32x4 v[8]; float ss = 0.f;
#pragma unroll
            for (int j = 0; j < 8; ++j) {
                if (XBF16) { const v2u w2 = rawb[j]; v[j] = (f32x4){bf_lo(w2.x), bf_hi(w2.x), bf_lo(w2.y), bf_hi(w2.y)}; rawb[j] = ((const GAS v2u*)((const bf16_t*)X + rnx * D))[lane + 64 * j]; }
                else { v[j] = rawf[j]; rawf[j] = ((const GAS f32x4*)((const float*)X + rnx * D))[lane + 64 * j]; }
                ss += (v[j][0] * v[j][0] + v[j][1] * v[j][1]) + (v[j][2] * v[j][2] + v[j][3] * v[j][3]); }
            const float rinv = 1.0f / sqrtf(wave_sum(ss) * (1.0f / D) + EPS);
            float amax = 0.f;
#pragma unroll
            for (int j = 0; j < 8; ++j) { const f32x4 a = *(const LAS f32x4*)(tabA + 4 * lane + 256 * j), bb = *(const LAS f32x4*)(tabB + 4 * lane + 256 * j);
                v[j] = v[j] * rinv * a + bb; amax = fmaxf(fmaxf(amax, fmaxf(fabsf(v[j][0]), fabsf(v[j][1]))), fmaxf(fabsf(v[j][2]), fabsf(v[j][3]))); }
#pragma unroll
            for (int o = 1; o < 64; o <<= 1) amax = fmaxf(amax, __shfl_xor(amax, o));
            const float qs = amax > 0.f ? 127.0f / amax : 0.f;
#pragma unroll
            for (int j = 0; j < 8; ++j) ((GAS unsigned*)(H + row * D))[lane + 64 * j] = pg8::pk4_i8(v[j][0] * qs, v[j][1] * qs, v[j][2] * qs, v[j][3] * qs);
            if (lane == 0) SA[row] = amax * (1.0f / 127.0f);
            if (MOE) {
                float lg[8];
#pragma unroll
                for (int e = 0; e < 8; ++e) { float s = 0.f;
#pragma unroll
                    for (int j = 0; j < 8; ++j) { const f32x4 w4 = *(const LAS f32x4*)(WrT + e * D + 4 * lane + 256 * j); s += (v[j][0] * w4[0] + v[j][1] * w4[1]) + (v[j][2] * w4[2] + v[j][3] * w4[3]); }
                    lg[e] = wave_sum(s); }
                int e0 = 0; float v0 = lg[0];
#pragma unroll
                for (int e = 1; e < 8; ++e) if (lg[e] > v0) { v0 = lg[e]; e0 = e; }
                int e1 = -1; float v1 = -3.0e38f;
#pragma unroll
                for (int e = 0; e < 8; ++e) if (e != e0 && lg[e] > v1) { v1 = lg[e]; e1 = e; }
                const float w0 = 1.0f / (1.0f + __expf(v1 - v0));
                if (lane == 0) { TOKE[2 * row] = e0; TOKE[2 * row + 1] = e1; TOKW[2 * row] = w0; TOKW[2 * row + 1] = 1.0f - w0; lds_add((cnt + e0), 1); lds_add((cnt + e1), 1); }
            }
        }
        __syncthreads();
        if (MOE && tid < 8) CNT[rb * 8 + tid] = cnt[tid];
        __syncthreads();
    }
}

__device__ __forceinline__ void moe_slots(LAS unsigned char* lds, const unsigned char* H, const float* SA, const int* TOKE, const int* CNT, int* SLOT, int* GT, unsigned char* XG, float* SAg, int G) {
    LAS int* tot = (LAS int*)lds; LAS int* pre = tot + 8; LAS int* basee = tot + 16; LAS int* padn = tot + 24; LAS int* pads = tot + 32; LAS int* eArr = tot + 64; LAS int* sArr = tot + 192;
    const int tid = threadIdx.x, lane = tid & 63, wave = tid >> 6;
    for (int rb = blockIdx.x; rb < T / 64; rb += G) {
        if (tid < 16) tot[tid] = 0;
        __syncthreads();
        { const int wq = tid >> 1, hf = tid & 1; const int4 c4 = *(const int4*)(CNT + wq * 8 + hf * 4); const bool lt = wq < rb;
          lds_add((tot + hf * 4 + 0), c4.x); lds_add((tot + hf * 4 + 1), c4.y); lds_add((tot + hf * 4 + 2), c4.z); lds_add((tot + hf * 4 + 3), c4.w);
          if (lt) { lds_add((pre + hf * 4 + 0), c4.x); lds_add((pre + hf * 4 + 1), c4.y); lds_add((pre + hf * 4 + 2), c4.z); lds_add((pre + hf * 4 + 3), c4.w); } }
        __syncthreads();
        if (tid == 0) { int rt = 0;
            for (int e = 0; e < 8; ++e) { const int n = (tot[e] + 255) >> 8; basee[e] = rt * 256 + pre[e]; pads[e] = rt * 256 + tot[e]; padn[e] = n * 256 - tot[e];
                if (rb == 0) { GT[e] = rt; GT[8 + e] = n; } rt += n; } }
        if (tid < 128) eArr[tid] = TOKE[(size_t)rb * 128 + tid];
        __syncthreads();
        if (tid < 128) { const int e = eArr[tid]; int rank = 0; for (int p = 0; p < tid; ++p) rank += (eArr[p] == e) ? 1 : 0;
            const int slot = basee[e] + rank; sArr[tid] = slot; SLOT[(size_t)rb * 128 + tid] = slot; SAg[slot] = SA[(size_t)rb * 64 + (tid >> 1)]; }
        __syncthreads();
        for (int tk = wave * 8; tk < wave * 8 + 8; tk += 4) {
            v4u a[4][2];
#pragma unroll
            for (int q = 0; q < 4; ++q) { const GAS v4u* s = (const GAS v4u*)(H + ((size_t)rb * 64 + tk + q) * D) + lane; a[q][0] = s[0]; a[q][1] = s[64]; }
#pragma unroll
            for (int q = 0; q < 4; ++q) {
                GAS v4u* d0 = (GAS v4u*)(XG + (size_t)sArr[2 * (tk + q)] * D) + lane; GAS v4u* d1 = (GAS v4u*)(XG + (size_t)sArr[2 * (tk + q) + 1] * D) + lane;
                d0[0] = a[q][0]; d0[64] = a[q][1]; d1[0] = a[q][0]; d1[64] = a[q][1]; }
        }
        if (rb < padn[wave]) { GAS v4u* d = (GAS v4u*)(XG + (size_t)(pads[wave] + rb) * D) + lane; const v4u z = {0u, 0u, 0u, 0u}; d[0] = z; d[64] = z; if (lane == 0) SAg[pads[wave] + rb] = 0.f; }
        __syncthreads();
    }
}
constexpr int SLOT_SPLIT = 128 * 256; constexpr size_t YP_STRIDE = (size_t)8 * 256 * D;
__device__ __forceinline__ f32x4 load_y4(const bf16_t* Y, const bf16_t* YP, int slot, int idx) {
    if (slot < SLOT_SPLIT) { const v2u a = ((const GAS v2u*)(Y + (size_t)slot * D))[idx]; return (f32x4){bf_lo(a.x), bf_hi(a.x), bf_lo(a.y), bf_hi(a.y)}; }
    f32x4 r = {0.f, 0.f, 0.f, 0.f};
#pragma unroll
    for (int p = 0; p < 4; ++p) { const v2u a = ((const GAS v2u*)(YP + p * YP_STRIDE + (size_t)(slot - SLOT_SPLIT) * D))[idx]; r += (f32x4){bf_lo(a.x), bf_hi(a.x), bf_lo(a.y), bf_hi(a.y)}; }
    return r;
}
__device__ __forceinline__ void moe_combine(const bf16_t* X1, const bf16_t* Y, const bf16_t* YP, const int* SLOT, const float* TOKW, const float* gate, float* out, int vcu, int G) {
    const int lane = threadIdx.x & 63, wave = threadIdx.x >> 6;
    for (int row = vcu * 8 + wave; row < T; row += G * 8) {
        const int s0 = SLOT[2 * row], s1 = SLOT[2 * row + 1]; const float w0 = TOKW[2 * row], w1 = TOKW[2 * row + 1];
        const GAS v2u* x = (const GAS v2u*)(X1 + (size_t)row * D) + lane;
        const GAS f32x4* g = (const GAS f32x4*)(gate + (size_t)(row >> 12) * MODW) + lane; GAS f32x4* o = (GAS f32x4*)(out + (size_t)row * D) + lane;
        if (s0 < SLOT_SPLIT && s1 < SLOT_SPLIT) {
            const GAS v2u* y0 = (const GAS v2u*)(Y + (size_t)s0 * D) + lane; const GAS v2u* y1 = (const GAS v2u*)(Y + (size_t)s1 * D) + lane;
#pragma unroll
            for (int j = 0; j < 8; ++j) { const v2u a = y0[64 * j], b = y1[64 * j];
                const f32x4 ya = {bf_lo(a.x), bf_hi(a.x), bf_lo(a.y), bf_hi(a.y)}, yb = {bf_lo(b.x), bf_hi(b.x), bf_lo(b.y), bf_hi(b.y)};
                const v2u xw = x[64 * j]; const f32x4 xv = {bf_lo(xw.x), bf_hi(xw.x), bf_lo(xw.y), bf_hi(xw.y)};
                o[64 * j] = xv + g[64 * j] * (ya * w0 + yb * w1); }
        } else {
            const bool sp0 = s0 >= SLOT_SPLIT, sp1 = s1 >= SLOT_SPLIT;
            const GAS v2u* p0 = (const GAS v2u*)(sp0 ? YP + (size_t)(s0 - SLOT_SPLIT) * D : Y + (size_t)s0 * D) + lane; const size_t st0 = sp0 ? YP_STRIDE / 4 : 0;
            const GAS v2u* p1 = (const GAS v2u*)(sp1 ? YP + (size_t)(s1 - SLOT_SPLIT) * D : Y + (size_t)s1 * D) + lane; const size_t st1 = sp1 ? YP_STRIDE / 4 : 0;
            const float m0 = sp0 ? w0 : 0.f, m1 = sp1 ? w1 : 0.f;
#pragma unroll
            for (int j = 0; j < 8; ++j) { f32x4 acc4 = {0.f, 0.f, 0.f, 0.f};
#pragma unroll
                for (int p = 0; p < 4; ++p) { const v2u a = p0[64 * j + p * st0], b = p1[64 * j + p * st1]; const float wa = p ? m0 : w0, wb = p ? m1 : w1;
                    acc4 += (f32x4){bf_lo(a.x), bf_hi(a.x), bf_lo(a.y), bf_hi(a.y)} * wa + (f32x4){bf_lo(b.x), bf_hi(b.x), bf_lo(b.y), bf_hi(b.y)} * wb; }
                const v2u xw = x[64 * j]; const f32x4 xv = {bf_lo(xw.x), bf_hi(xw.x), bf_lo(xw.y), bf_hi(xw.y)};
                o[64 * j] = xv + g[64 * j] * acc4; }
        }
    }
}

__device__ __forceinline__ void attn_conv_phase(LAS unsigned char* lds, const bf16_t* Q, const bf16_t* Kb, const bf16_t* Vb, const bf16_t* BC, const bf16_t* U, const float* convw, const float* sinks,
                                                bf16_t* AC, int G) {
    constexpr int KSTR = 144, VSTR = 560;
    LAS unsigned char* Ks = lds; LAS unsigned char* Vt = lds + 256 * KSTR;
    const int tid = threadIdx.x, lane = tid & 63, wave = tid >> 6, fr = lane & 15, fq = lane >> 4;
    for (int unit = blockIdx.x; unit < NBATCH * 32 * 4; unit += G) {
        const int kvh = unit & 3, nb = (unit >> 2) & 31, b = unit >> 7;
        const long tok0 = (long)b * SEQ + nb * 128 - 128;
        __syncthreads();
#pragma unroll
        for (int i = 0; i < 4; ++i) { const int task = tid + 512 * i, krel = task >> 3, ch = task & 7; v4u val = {0u, 0u, 0u, 0u};
            if (nb > 0 || krel >= 128) val = *(const GAS v4u*)(Kb + (size_t)(tok0 + krel) * DKV + kvh * 64 + ch * 8);
            *(LAS v4u*)(Ks + krel * KSTR + ch * 16) = val; }
#pragma unroll
        for (int i = 0; i < 4; ++i) { const int task = tid + 512 * i, krel = task & 255, ch = task >> 8; v4u val = {0u, 0u, 0u, 0u};
            if (nb > 0 || krel >= 128) val = *(const GAS v4u*)(Vb + (size_t)(tok0 + krel) * DKV + kvh * 64 + ch * 8);
            LAS unsigned short* vp = (LAS unsigned short*)(Vt + (ch * 8) * VSTR + krel * 2);
            vp[0 * (VSTR / 2)] = (unsigned short)(val.x & 0xffffu); vp[1 * (VSTR / 2)] = (unsigned short)(val.x >> 16); vp[2 * (VSTR / 2)] = (unsigned short)(val.y & 0xffffu); vp[3 * (VSTR / 2)] = (unsigned short)(val.y >> 16);
            vp[4 * (VSTR / 2)] = (unsigned short)(val.z & 0xffffu); vp[5 * (VSTR / 2)] = (unsigned short)(val.z >> 16); vp[6 * (VSTR / 2)] = (unsigned short)(val.w & 0xffffu); vp[7 * (VSTR / 2)] = (unsigned short)(val.w >> 16); }
        { const int d = tid >> 3, c = tid & 7; *(LAS unsigned*)(Vt + d * VSTR + 512 + c * 4) = 0u; }
        const int hq = kvh * 4 + (wave >> 1), half = wave & 1;
        const bf16_t* qbase = Q + ((size_t)b * SEQ + nb * 128 + half * 64 + fr) * DATT + hq * 64 + fq * 8;
        bf16x8 qn0 = *(const GAS bf16x8*)qbase, qn1 = *(const GAS bf16x8*)(qbase + 32);
        __syncthreads();
        const float slope2 = __builtin_amdgcn_exp2f(-0.5f * (float)(hq + 1)) * LOG2E, sink2 = sinks[hq] * LOG2E;
        for (int st = 0; st < 4; ++st) {
            const int i0 = half * 64 + st * 16, t0 = i0 >> 4;
            const size_t qrow = (size_t)b * SEQ + nb * 128 + i0 + fr;
            const bf16x8 qf0 = qn0, qf1 = qn1;
            if (st < 3) { qn0 = *(const GAS bf16x8*)(qbase + (size_t)(st + 1) * 16 * DATT); qn1 = *(const GAS bf16x8*)(qbase + (size_t)(st + 1) * 16 * DATT + 32); }
            f32x4 S[9];
#pragma unroll
            for (int tt = 0; tt < 9; ++tt) { const LAS unsigned char* kp = Ks + (16 * (t0 + tt) + fr) * KSTR + fq * 16;
                const bf16x8 k0 = *(const LAS bf16x8*)kp, k1 = *(const LAS bf16x8*)(kp + 64);
                f32x4 s = {0.f, 0.f, 0.f, 0.f};
                s = __builtin_amdgcn_mfma_f32_16x16x32_bf16(k0, qf0, s, 0, 0, 0); s = __builtin_amdgcn_mfma_f32_16x16x32_bf16(k1, qf1, s, 0, 0, 0); S[tt] = s; }
            const int df = fr - 4 * fq; float mx = sink2;
#pragma unroll
            for (int tt = 0; tt < 9; ++tt)
#pragma unroll
                for (int j = 0; j < 4; ++j) { const int dist = 128 - 16 * tt + df - j; bool valid = true;
                    if (tt == 0) valid = (df - j) < 0; if (tt == 8) valid = (df - j) >= 0; if (nb == 0 && t0 + tt < 8) valid = false;
                    const float lg = valid ? (S[tt][j] - slope2 * (float)dist) : -__builtin_inff(); S[tt][j] = lg; mx = fmaxf(mx, lg); }
            mx = fmaxf(mx, __shfl_xor(mx, 16)); mx = fmaxf(mx, __shfl_xor(mx, 32));
            float lsum = 0.f;
#pragma unroll
            for (int tt = 0; tt < 9; ++tt)
#pragma unroll
                for (int j = 0; j < 4; ++j) { const float p = __builtin_amdgcn_exp2f(S[tt][j] - mx); S[tt][j] = p; lsum += p; }
            lsum += __shfl_xor(lsum, 16); lsum += __shfl_xor(lsum, 32); lsum += __builtin_amdgcn_exp2f(sink2 - mx);
            const float inv = 1.0f / lsum;
            f32x4 O[4];
#pragma unroll
            for (int dt = 0; dt < 4; ++dt) O[dt] = (f32x4){0.f, 0.f, 0.f, 0.f};
#pragma unroll
            for (int uu = 0; uu < 5; ++uu) {
                v4u pw; pw.x = pg8::cvt_pk_bf16(S[2 * uu][0], S[2 * uu][1]); pw.y = pg8::cvt_pk_bf16(S[2 * uu][2], S[2 * uu][3]);
                if (uu < 4) { pw.z = pg8::cvt_pk_bf16(S[2 * uu + 1 > 8 ? 8 : 2 * uu + 1][0], S[2 * uu + 1 > 8 ? 8 : 2 * uu + 1][1]); pw.w = pg8::cvt_pk_bf16(S[2 * uu + 1 > 8 ? 8 : 2 * uu + 1][2], S[2 * uu + 1 > 8 ? 8 : 2 * uu + 1][3]); }
                else { pw.z = 0u; pw.w = 0u; }
                const bf16x8 pb = __builtin_bit_cast(bf16x8, pw);
#pragma unroll
                for (int dt = 0; dt < 4; ++dt) { const LAS unsigned char* vp = Vt + (16 * dt + fr) * VSTR + (16 * (t0 + 2 * uu) + 4 * fq) * 2;
                    const s16x4 lo = *(const LAS s16x4*)vp, hi = *(const LAS s16x4*)(vp + 32);
                    const bf16x8 va = __builtin_shufflevector(lo, hi, 0, 1, 2, 3, 4, 5, 6, 7);
                    O[dt] = __builtin_amdgcn_mfma_f32_16x16x32_bf16(va, pb, O[dt], 0, 0, 0); }
            }
            bf16_t* op = AC + qrow * DATT + hq * 64 + 4 * fq;
#pragma unroll
            for (int dt = 0; dt < 4; ++dt) { v2u o; o.x = pg8::cvt_pk_bf16(O[dt][0] * inv, O[dt][1] * inv); o.y = pg8::cvt_pk_bf16(O[dt][2] * inv, O[dt][3] * inv); *(GAS v2u*)(op + 16 * dt) = o; }
        }
    }
    bf16_t* CO = AC + (size_t)T * DATT;
    for (int rb = blockIdx.x; rb < T / 64; rb += G) {
#pragma unroll 4
        for (int i = 0; i < 16; ++i) { const int task = tid + 512 * i; const size_t row = (size_t)rb * 64 + (task >> 7); const int ch0 = (task & 127) * 8, tseq = (int)(row & (SEQ - 1));
            const v4u z = {0u, 0u, 0u, 0u};
            const v4u u0 = *(const GAS v4u*)(U + row * DCONV + ch0), u1 = tseq >= 1 ? *(const GAS v4u*)(U + (row - 1) * DCONV + ch0) : z, u2 = tseq >= 2 ? *(const GAS v4u*)(U + (row - 2) * DCONV + ch0) : z;
            const v4u bc = *(const GAS v4u*)(BC + row * DCONV + ch0);
            f32x4 a0, b0, a1, b1, a2, b2, ab, bb; pg8::unpack8(u0, a0, b0); pg8::unpack8(u1, a1, b1); pg8::unpack8(u2, a2, b2); pg8::unpack8(bc, ab, bb);
            const f32x4 w0a = *(const f32x4*)(convw + ch0), w0b = *(const f32x4*)(convw + ch0 + 4), w1a = *(const f32x4*)(convw + DCONV + ch0), w1b = *(const f32x4*)(convw + DCONV + ch0 + 4),
                        w2a = *(const f32x4*)(convw + 2 * DCONV + ch0), w2b = *(const f32x4*)(convw + 2 * DCONV + ch0 + 4);
            const f32x4 ya = ab * (w0a * a2 + w1a * a1 + w2a * a0), yb = bb * (w0b * b2 + w1b * b1 + w2b * b0);
            *(GAS v4u*)(CO + row * DCONV + ch0) = pg8::pack8(ya, yb); }
    }
}

constexpr int N_PHASES = 19;
#define RUN(k) (lo <= (k) && (k) < hi)
#define SEAM(k) do { if (RUN(k) && RUN((k) + 1)) { XcdBarrier b2_ = bar; unsigned char* ws_ = WSB(); b2_.bar = (unsigned*)(ws_ + WS_CTL) + CW_BAR; xcd_barrier_work(b2_, lds, args, (unsigned*)(ws_ + WS_CTL + 49152)); } } while (0)
#define WSB() ({ GAS unsigned char* _w = (GAS unsigned char*)args.ws; asm volatile("" : "+s"(_w)); (unsigned char*)_w; })
#define INP(i) ((const float*)(const GAS float*)args.in[i])
#define WP(type, off) ((type*)(ws + (off)))
template <int l>
__device__ __forceinline__ void layer_phases(const Args& args, LAS unsigned char* lds, const XcdBarrier& bar, const int lo, const int hi, const int G, const int bx, const int vcu) {
        const int pb = l * 8;
        if (RUN(pb + 1)) { unsigned char* ws = WSB(); const float* modl = WP(float, WS_MOD) + (size_t)l * NBATCH * MODW;
            if (l == 0) norm_phase<false, false>(lds, INP(0), INP(4) + l * D, modl + 1 * D, modl + 0 * D, WP(unsigned char, WS_H), WP(float, WS_MOE + 458752), nullptr, nullptr, nullptr, nullptr, G);
            else norm_phase<false, true>(lds, WP(bf16_t, WS_X2), INP(4) + l * D, modl + 1 * D, modl + 0 * D, WP(unsigned char, WS_H), WP(float, WS_MOE + 458752), nullptr, nullptr, nullptr, nullptr, G); }
        SEAM(pb + 1);
        if (RUN(pb + 2)) { unsigned char* ws = WSB();
            pg8::Gemm g{WP(bf16_t, WS_H), (const bf16_t*)(WP(unsigned char, WS_WIN) + (size_t)l * DIN * D), T, DIN, D / 2}; pg8::StaticOrder S; S.init(T, DIN, G, bx);
            pg8::EpiWin E{WP(bf16_t, WS_Q), WP(bf16_t, WS_K), WP(bf16_t, WS_V), WP(bf16_t, WS_BC), WP(bf16_t, WS_U), WP(bf16_t, WS_R), WP(bf16_t, WS_GC), INP(6) + l * 64, INP(7) + l * 64, WP(float, WS_MOE + 458752), 1.0f / W8I_SCALE};
            pg8::gemm_phase<pg8::EpiWin, pg8::StaticOrder, true, true, 2>(lds, g, S, E);
        }
        SEAM(pb + 2);
        if (RUN(pb + 3)) { unsigned char* ws = WSB();
            attn_conv_phase(lds, WP(bf16_t, WS_Q), WP(bf16_t, WS_K), WP(bf16_t, WS_V), WP(bf16_t, WS_BC), WP(bf16_t, WS_U), INP(9) + (size_t)l * 3 * DCONV, INP(8) + l * 16, WP(bf16_t, WS_AC), G); }
        SEAM(pb + 3);
        if (RUN(pb + 4)) { unsigned char* ws = WSB();
            pg8::Gemm g{WP(bf16_t, WS_AC), WP(bf16_t, WS_WAC) + (size_t)l * 2 * D * DATT, 2 * T, 2 * D, DATT}; pg8::MergeOrder S; S.init(G, bx);
            pg8::EpiMerge E{WP(bf16_t, WS_R), WP(bf16_t, WS_GC), WP(bf16_t, WS_MG)};
            pg8::gemm_phase<pg8::EpiMerge, pg8::MergeOrder, true, true>(lds, g, S, E);
        }
        SEAM(pb + 4);
        if (RUN(pb + 5)) { unsigned char* ws = WSB(); const float* modl = WP(float, WS_MOD) + (size_t)l * NBATCH * MODW;
            pg8::Gemm g{WP(bf16_t, WS_MG), WP(bf16_t, WS_WOUT) + (size_t)l * D * D, T, D, D}; pg8::StaticOrder S; S.init(T, D, G, bx);
            if (l == 0) { pg8::EpiResid<false> E{INP(0), WP(bf16_t, WS_X1), modl + 2 * D}; pg8::gemm_phase<pg8::EpiResid<false>, pg8::StaticOrder, true, true>(lds, g, S, E); }
            else { pg8::EpiResid<true> E{WP(bf16_t, WS_X2), WP(bf16_t, WS_X1), modl + 2 * D}; pg8::gemm_phase<pg8::EpiResid<true>, pg8::StaticOrder, true, true>(lds, g, S, E); }
        }
        SEAM(pb + 5);
        if (RUN(pb + 6)) { unsigned char* ws = WSB(); const float* modl = WP(float, WS_MOD) + (size_t)l * NBATCH * MODW;
            if (l == 0) norm_phase<false, true>(lds, WP(bf16_t, WS_X1), INP(13) + l * D, modl + 4 * D, modl + 3 * D, WP(unsigned char, WS_H), WP(float, WS_MOE + 458752), nullptr, nullptr, nullptr, nullptr, G);
            else        norm_phase<true, true>(lds, WP(bf16_t, WS_X1), INP(13) + l * D, modl + 4 * D, modl + 3 * D, WP(unsigned char, WS_H), WP(float, WS_MOE + 458752), INP(16), WP(int, WS_MOE + 65536), WP(float, WS_MOE + 196608), WP(int, WS_MOE), G);
        }
        if (l == 0 && RUN(pb + 6)) { unsigned char* ws = WSB(); moe_tiles_rest(lds, args, WP(unsigned, WS_CTL + 49152), (unsigned)NT_FFN); }
        SEAM(pb + 6);
        if constexpr (l == 0) {
            if (RUN(7)) { unsigned char* ws = WSB();
                pg8::Gemm g{WP(bf16_t, WS_H), WP(bf16_t, WS_WGU), T, 2 * DFF, D / 2}; pg8::StaticOrder S; S.init(T, 2 * DFF, G, bx);
                pg8::EpiSwiglu8 E{WP(unsigned char, WS_ACT), DFF, 2 * DFF / 256, WP(float, WS_MOE + 458752), 1.0f / W8I_SCALE};
                pg8::gemm_phase<pg8::EpiSwiglu8, pg8::StaticOrder, true, true, 2>(lds, g, S, E);
            }
            SEAM(7);
            if (RUN(8)) { unsigned char* ws = WSB(); const float* modl = WP(float, WS_MOD);
                pg8::Gemm g{WP(bf16_t, WS_ACT), WP(bf16_t, WS_WDN), T, D, DFF / 2, ((127 - 2) << 8) | (127 - MDN8_LOG2)}; pg8::StaticOrder S; S.init(T, D, G, bx);
                pg8::EpiResid<true> E{WP(bf16_t, WS_X1), WP(bf16_t, WS_X2), modl + 5 * D};
                pg8::gemm_phase<pg8::EpiResid<true>, pg8::StaticOrder, true, true, 1>(lds, g, S, E);
            }
            SEAM(8);
        } else {
            if (RUN(15)) { unsigned char* ws = WSB(); moe_slots(lds, WP(unsigned char, WS_H), WP(float, WS_MOE + 458752), WP(int, WS_MOE + 65536), WP(int, WS_MOE), WP(int, WS_MOE + 327680), WP(int, WS_MOE + 16384), WP(unsigned char, WS_XG), WP(float, WS_MOE + 524288), G); }
            if (RUN(15)) { unsigned char* ws = WSB(); moe_tiles_rest(lds, args, WP(unsigned, WS_CTL + 49152), (unsigned)NQ_GU_END); }
            SEAM(15);
            if (RUN(16)) { unsigned char* ws = WSB();
                pg8::Gemm g{WP(bf16_t, WS_XG), WP(bf16_t, WS_MGU), NSLOT, NEXP * 2 * MFF, D / 2}; pg8::GroupedOrder S; S.init((LAS int*)(lds + LDSCTL_OFF + 1024), WP(int, WS_MOE + 16384), 2 * MFF / 256, G, bx);
                pg8::EpiSwiglu8 E{WP(unsigned char, WS_ACT), MFF, 2 * MFF / 256, WP(float, WS_MOE + 524288), 1.0f / W8I_SCALE};
                pg8::gemm_phase<pg8::EpiSwiglu8, pg8::GroupedOrder, true, true, 2>(lds, g, S, E);
                moe_tiles_rest(lds, args, WP(unsigned, WS_CTL + 49152), (unsigned)NQ_ALL);
            }
            SEAM(16);
            if (RUN(17)) { unsigned char* ws = WSB();
                pg8::GroupedOrder S0; S0.init((LAS int*)(lds + LDSCTL_OFF + 1024), WP(int, WS_MOE + 16384), D / 256, G, bx);
                const int ntiles = S0.total / (D / 256);
                { pg8::Gemm g{WP(bf16_t, WS_ACT), WP(bf16_t, WS_MDN), NSLOT, NEXP * D, MFF / 2, ((127 - 2) << 8) | (127 - MDN8_LOG2)};
                  pg8::DownMainOrder S; S.init((LAS int*)(lds + LDSCTL_OFF + 1024), G, bx);
                  pg8::EpiY E{WP(bf16_t, WS_Y), 0};
                  pg8::gemm_phase<pg8::EpiY, pg8::DownMainOrder, true, true, 1>(lds, g, S, E); }
                { const size_t koff = (size_t)(bx & 3) * (MFF / 4);
                  pg8::Gemm g{(const bf16_t*)(WP(unsigned char, WS_ACT) + koff), (const bf16_t*)(WP(unsigned char, WS_MDN) + koff), NSLOT, NEXP * D, MFF / 2, ((127 - 2) << 8) | (127 - MDN8_LOG2), MFF / 8};
                  pg8::DownSpillOrder S; S.init((LAS int*)(lds + LDSCTL_OFF + 1024), bx, ntiles);
                  pg8::EpiY E{WP(bf16_t, WS_Y + 136 * MiB) + (size_t)(bx & 3) * YP_STRIDE, 128};
                  pg8::gemm_phase<pg8::EpiY, pg8::DownSpillOrder, true, true, 1>(lds, g, S, E); }
            }
            SEAM(17);
            if (RUN(18)) { unsigned char* ws = WSB(); const float* modl = WP(float, WS_MOD) + (size_t)NBATCH * MODW;
                moe_combine(WP(bf16_t, WS_X1), WP(bf16_t, WS_Y), WP(bf16_t, WS_Y + 136 * MiB), WP(int, WS_MOE + 327680), WP(float, WS_MOE + 196608), modl + 5 * D, args.out, vcu, G); }
        }
}
__global__ void __launch_bounds__(512, 2) mk_fwd(Args args) {
    extern __shared__ __attribute__((aligned(16))) unsigned char lds_raw[];
    LAS unsigned char* lds = (LAS unsigned char*)lds_raw;
    const int tid = threadIdx.x;
    const int G = gridDim.x; const int bx = blockIdx.x; const int vcu = (G % 8 == 0) ? (bx % 8) * (G / 8) + bx / 8 : bx;
    unsigned* ctl = (unsigned*)(GAS unsigned*)(args.ws + WS_CTL);
    for (int u = tid; u < (LDS_BYTES - LDSCTL_OFF) / 4; u += 512) ((LAS unsigned*)(lds + LDSCTL_OFF))[u] = 0u;
    __syncthreads();
    XcdBarrier bar = xcd_barrier_post(ctl + CW_BAR, (volatile LAS unsigned*)(lds + MISC_OFF) + 8);
    const int lo = args.ph_lo, hi = args.ph_hi;


    if (RUN(0)) {
        unsigned char* ws = WSB();
        p0_mod(lds, INP(1), INP(2), INP(3), WP(float, WS_MOD), G);
        Wts w; w.w_in = INP(5); w.w_ab = INP(10); w.w_cb = INP(11); w.w_out = INP(12); w.ffn_gu = INP(14); w.ffn_dn = INP(15); w.moe_gu = INP(17); w.moe_dn = INP(18);
        w.WIN = WP(unsigned char, WS_WIN); w.WAC = WP(bf16_t, WS_WAC); w.WOUT = WP(bf16_t, WS_WOUT); w.WGU = WP(unsigned char, WS_WGU); w.WDN = WP(unsigned char, WS_WDN); w.MGU = WP(unsigned char, WS_MGU); w.MDN = WP(unsigned char, WS_MDN);
        p0_convert(lds, w, vcu, G);
    }
    SEAM(0);
    layer_phases<0>(args, lds, bar, lo, hi, G, bx, vcu);
    layer_phases<1>(args, lds, bar, lo, hi, G, bx, vcu);
}

extern "C" void kernel_launch(void* const* d_in, const int* in_sizes, int n_in, void* d_out, int out_size, void* d_ws, size_t ws_size, hipStream_t stream) {
    static int grid = 0;
    if (grid == 0) {
        if (n_in != 19 || in_sizes[0] != T * D || out_size != T * D || ws_size < WS_END) { fprintf(stderr, "kernel_launch: unexpected problem (n_in %d, x %d, out %d, ws %zu < %zu); nothing launched\n", n_in, n_in > 0 ? in_sizes[0] : -1, out_size, ws_size, (size_t)WS_END); grid = -1; return; }
        int dev = 0, cus = 0, per_cu = 0;
        if (hipGetDevice(&dev) != hipSuccess || hipDeviceGetAttribute(&cus, hipDeviceAttributeMultiprocessorCount, dev) != hipSuccess) { fprintf(stderr, "kernel_launch: device query failed\n"); grid = -1; return; }
        if (hipFuncSetAttribute((const void*)mk_fwd, hipFuncAttributeMaxDynamicSharedMemorySize, LDS_BYTES) != hipSuccess) { fprintf(stderr, "kernel_launch: hipFuncSetAttribute failed\n"); grid = -1; return; }
        if (hipOccupancyMaxActiveBlocksPerMultiprocessor(&per_cu, (const void*)mk_fwd, 512, LDS_BYTES) != hipSuccess || per_cu < 1) fprintf(stderr, "kernel_launch: note: occupancy query reports %d workgroups per CU\n", per_cu);
        (void)hipGetLastError();
        grid = cus;
    }
    if (grid < 0) return;
    if (hipMemsetAsync((char*)d_ws + WS_CTL, 0, CTL_ZERO_BYTES, stream) != hipSuccess) { fprintf(stderr, "kernel_launch: memset failed\n"); return; }
    Args a{};
    for (int i = 0; i < 19; ++i) a.in[i] = (const float*)d_in[i];
    a.out = (float*)d_out; a.ws = (unsigned char*)d_ws;
#if MK_N_LAUNCHES == 1
    a.ph_lo = 0; a.ph_hi = N_PHASES;
    hipLaunchKernelGGL(mk_fwd, dim3(grid), dim3(512), LDS_BYTES, stream, a);
#else
    for (int p = 0; p < N_PHASES; ++p) { a.ph_lo = p; a.ph_hi = p + 1; const int reps = ((MK_PROBE_MASK >> p) & 1) ? 2 : 1;
        for (int r = 0; r < reps; ++r) hipLaunchKernelGGL(mk_fwd, dim3(grid), dim3(512), LDS_BYTES, stream, a); }
#endif
    const hipError_t le = hipPeekAtLastError();
    if (le != hipSuccess) fprintf(stderr, "kernel_launch: launch failed: %s\n", hipGetErrorName(le));
}
```

```cpp
#include <hip/hip_runtime.h>
#include <cstdio>
#include <cstdint>

#ifndef MK_PROBE_MASK
#define MK_PROBE_MASK 0
#endif
#ifndef MK_N_LAUNCHES
#define MK_N_LAUNCHES 1
#endif

constexpr int T = 16384, SEQ = 4096, NBATCH = 4, D = 2048, DIN = 8704, DATT = 1024, DKV = 256, DCONV = 1024, DFF = 5632, MFF = 7168, NEXP = 8;
constexpr int MODW = 6 * D;
constexpr int NSLOT = 2 * T + NEXP * 256;
constexpr float EPS = 1e-6f;
constexpr float LOG2E = 1.4426950408889634f;
constexpr float ACT8_SCALE = 4.0f;
constexpr int MDN8_LOG2 = 7;
constexpr float W8I_SCALE = 1448.0f;
constexpr float QSCALE = 0.125f * LOG2E;

constexpr size_t MiB = (size_t)1 << 20;
constexpr size_t WS_CTL = 0, CTL_ZERO_BYTES = 1 * MiB;
constexpr size_t WS_MOD = 1 * MiB;
constexpr size_t WS_MOE = 2 * MiB;
constexpr size_t WS_WIN = 4 * MiB;
constexpr size_t WS_WAC = 72 * MiB;
constexpr size_t WS_WOUT = 88 * MiB;
constexpr size_t WS_WGU = 104 * MiB;
constexpr size_t WS_WDN = 148 * MiB;
constexpr size_t WS_MGU = 170 * MiB;
constexpr size_t WS_MDN = 618 * MiB;
constexpr size_t WS_H = 842 * MiB;
constexpr size_t WS_Q = 906 * MiB;
constexpr size_t WS_K = 938 * MiB;
constexpr size_t WS_V = 946 * MiB;
constexpr size_t WS_BC = 954 * MiB;
constexpr size_t WS_U = 986 * MiB;
constexpr size_t WS_R = 1018 * MiB;
constexpr size_t WS_GC = 1082 * MiB;
constexpr size_t WS_AC = 1146 * MiB;
constexpr size_t WS_MG = 1210 * MiB;
constexpr size_t WS_X1 = 1274 * MiB;
constexpr size_t WS_X2 = 1402 * MiB;
constexpr size_t WS_ACT = 1530 * MiB;
constexpr size_t WS_XG = 2006 * MiB;
constexpr size_t WS_Y = 2142 * MiB;
constexpr size_t WS_END = 2414 * MiB;
constexpr int CW_BAR = 4096;

constexpr int RING_BYTES = 131072;
constexpr int LDSCTL_OFF = RING_BYTES, MISC_OFF = LDSCTL_OFF + 320;
constexpr int LDS_BYTES = 147456;

#define GAS __attribute__((address_space(1)))
#define LAS __attribute__((address_space(3)))
typedef unsigned v4u __attribute__((ext_vector_type(4)));
typedef unsigned v2u __attribute__((ext_vector_type(2)));
typedef short s16x4 __attribute__((ext_vector_type(4)));
#define LDS_WAIT() asm volatile("s_waitcnt lgkmcnt(0)" ::: "memory")
#define VM_WAIT() asm volatile("s_waitcnt vmcnt(0)" ::: "memory")

namespace pg8 {
#define PG8_LAS __attribute__((address_space(3)))
typedef unsigned short bf16_t;
typedef short bf16x8 __attribute__((ext_vector_type(8)));
typedef float f32x4 __attribute__((ext_vector_type(4)));
typedef unsigned u32x4 __attribute__((ext_vector_type(4)));
constexpr int BM = 256, BK = 64, HALF = 128, HTB = HALF * BK * 2  , STAGE_BYTES = 8 * HTB, NXCD = 8, WGM = 4;

__host__ __device__ __forceinline__ int lds_byte(int r, int c) { const int st = (r >> 4) * 2 + (c >> 5), rr = r & 15, cc = c & 31, ob = rr * 64 + cc * 2; return st * 1024 + (ob ^ (((ob >> 9) & 1) << 5)); }
__host__ __device__ __forceinline__ void stage_rc(int b, int& R, int& C) { const int st = b / 1024, sb = b % 1024, swz = sb ^ (((sb >> 9) & 1) << 5); R = (st >> 1) * 16 + swz / 64; C = (st & 1) * 32 + (swz % 64) / 2; }
__host__ __device__ __forceinline__ int perm32(int rho) { const int n = rho >> 4, i = rho & 15; return 8 * (i >> 2) + 4 * n + (i & 3); }

struct Unit { int pm, pn; };
struct Gemm { const bf16_t* A; const bf16_t* Bt; int M, N, K; int sB = 0x7f7f; int Kloop = 0; };
typedef int v8i __attribute__((ext_vector_type(8)));
typedef int v4i __attribute__((ext_vector_type(4)));

struct StaticOrder {
    int nM, nN, nwg, G, c;
    __host__ __device__ void init(int M, int N, int G_, int c_) { nM = M / BM; nN = N / BM; nwg = nM * nN; G = G_; c = c_; }
    __host__ __device__ bool next(int i, Unit& u) const {
        const long L = (long)i * G + c; if (L >= nwg) return false;
        int wgid = (int)L; { const int q = nwg / NXCD, r = nwg % NXCD, xcd = wgid % NXCD, off = wgid / NXCD; wgid = (xcd < r ? xcd * (q + 1) : r * (q + 1) + (xcd - r) * q) + off; }
        const int nig = WGM * nN, gid = wgid / nig, fm = gid * WGM, gsz = (nM - fm) < WGM ? (nM - fm) : WGM;
        u.pm = fm + ((wgid % nig) % gsz); u.pn = (wgid % nig) / gsz; return true;
    }
    __device__ __forceinline__ void a_ready(const Unit&) const {}
    __device__ __forceinline__ void done(const Unit&) const {}
};

__device__ __forceinline__ unsigned cvt_pk_bf16(float lo, float hi) { unsigned r; asm volatile("v_cvt_pk_bf16_f32 %0, %1, %2" : "=v"(r) : "v"(lo), "v"(hi)); return r; }
__device__ __forceinline__ u32x4 pack8(const f32x4 a, const f32x4 b) { u32x4 w; w.x = cvt_pk_bf16(a[0], a[1]); w.y = cvt_pk_bf16(a[2], a[3]); w.z = cvt_pk_bf16(b[0], b[1]); w.w = cvt_pk_bf16(b[2], b[3]); return w; }
__device__ __forceinline__ void unpack8(const u32x4 w, f32x4& a, f32x4& b) {
    a[0] = __uint_as_float(w.x << 16); a[1] = __uint_as_float(w.x & 0xffff0000u); a[2] = __uint_as_float(w.y << 16); a[3] = __uint_as_float(w.y & 0xffff0000u);
    b[0] = __uint_as_float(w.z << 16); b[1] = __uint_as_float(w.z & 0xffff0000u); b[2] = __uint_as_float(w.w << 16); b[3] = __uint_as_float(w.w & 0xffff0000u); }
__device__ __forceinline__ float fast_exp(float x) { return __builtin_amdgcn_exp2f(x * 1.4426950408889634f); }
__device__ __forceinline__ float sigmoid_f(float x) { return __builtin_amdgcn_rcpf(1.0f + fast_exp(-x)); }
__device__ __forceinline__ unsigned pk4_i8(float a, float b, float c, float d) {
    const int ia = (int)__builtin_rintf(__builtin_amdgcn_fmed3f(a, -127.0f, 127.0f)), ib = (int)__builtin_rintf(__builtin_amdgcn_fmed3f(b, -127.0f, 127.0f)),
              ic = (int)__builtin_rintf(__builtin_amdgcn_fmed3f(c, -127.0f, 127.0f)), id = (int)__builtin_rintf(__builtin_amdgcn_fmed3f(d, -127.0f, 127.0f));
    return ((unsigned)ia & 0xffu) | (((unsigned)ib & 0xffu) << 8) | (((unsigned)ic & 0xffu) << 16) | ((unsigned)id << 24); }
__device__ __forceinline__ void acc_i32_to_f32(f32x4 (&acc)[2][2][4][2], const float* rowscale, size_t row0, float wsc) {
#pragma unroll
    for (int ai = 0; ai < 2; ++ai)
#pragma unroll
        for (int m = 0; m < 4; ++m) { const float rs = rowscale[row0 + ai * HALF + m * 16] * wsc;
#pragma unroll
            for (int bj = 0; bj < 2; ++bj)
#pragma unroll
                for (int n = 0; n < 2; ++n) { const v4i iv = __builtin_bit_cast(v4i, acc[ai][bj][m][n]); acc[ai][bj][m][n] = (f32x4){(float)iv[0] * rs, (float)iv[1] * rs, (float)iv[2] * rs, (float)iv[3] * rs}; } }
}
__device__ __forceinline__ unsigned pk4_fp8(float a, float b, float c, float d) {
    a = __builtin_amdgcn_fmed3f(a, -448.0f, 448.0f); b = __builtin_amdgcn_fmed3f(b, -448.0f, 448.0f); c = __builtin_amdgcn_fmed3f(c, -448.0f, 448.0f); d = __builtin_amdgcn_fmed3f(d, -448.0f, 448.0f);
    int w = 0; w = __builtin_amdgcn_cvt_pk_fp8_f32(a, b, w, false); w = __builtin_amdgcn_cvt_pk_fp8_f32(c, d, w, true); return (unsigned)w; }

struct MergeOrder {
    StaticOrder so;
    __device__ void init(int G_, int c_) { so.init(16384, 2048, G_, c_); }
    __device__ bool next(int i, Unit& u) const { if (!so.next(i >> 1, u)) return false; if (i & 1) { u.pm += 64; u.pn += 8; } return true; }
    __device__ __forceinline__ void a_ready(const Unit&) const {}
    __device__ __forceinline__ void done(const Unit&) const {}
};
struct GroupedOrder {
    int NT, G, c, total; PG8_LAS int* tab;
    __device__ __forceinline__ void decode(int i, int& pm, int& pn) const {
        const int L = i * G + c; if (L >= total) { pm = -1; pn = 0; return; }
        int wgid = L; { const int q = total / NXCD, r = total % NXCD, xcd = wgid % NXCD, off = wgid / NXCD; wgid = (xcd < r ? xcd * (q + 1) : r * (q + 1) + (xcd - r) * q) + off; }
        int e = 0;
#pragma unroll
        for (int j = 1; j < 8; ++j) e += (wgid >= tab[j]) ? 1 : 0;
        const int base = tab[e], nM = tab[16 + e], r0 = tab[32 + e];
        const int idx = wgid - base, nig = WGM * NT, gid = idx / nig, fm = gid * WGM, gsz = (nM - fm) < WGM ? (nM - fm) : WGM, rem = idx % nig;
        pm = r0 + fm + rem % gsz; pn = e * NT + rem / gsz;
    }
    __device__ __forceinline__ void init(PG8_LAS int* tab_, const int* GT, int NT_, int G_, int c_) {
        NT = NT_; G = G_; c = c_; tab = tab_;
        __syncthreads();
        if (threadIdx.x == 0) { int up = 0; for (int e = 0; e < 8; ++e) { const int r = GT[e], n = GT[8 + e]; tab[e] = up; tab[16 + e] = n; tab[32 + e] = r; up += n * NT_; } tab[8] = up; }
        __syncthreads();
        total = __builtin_amdgcn_readfirstlane(tab[8]);
        if (threadIdx.x < 64) { int pm, pn; decode((int)threadIdx.x, pm, pn); tab[64 + 2 * threadIdx.x] = pm; tab[65 + 2 * threadIdx.x] = pn; }
        __syncthreads();
    }
    __device__ __forceinline__ bool next(int i, Unit& u) const {
        if (i >= 64) return false;
        const int pm = __builtin_amdgcn_readfirstlane(tab[64 + 2 * i]); if (pm < 0) return false;
        u.pm = pm; u.pn = __builtin_amdgcn_readfirstlane(tab[65 + 2 * i]); return true;
    }
    __device__ __forceinline__ void a_ready(const Unit&) const {}
    __device__ __forceinline__ void done(const Unit&) const {}
};

struct DownMainOrder {
    StaticOrder so; PG8_LAS int* tab;
    __device__ __forceinline__ void init(PG8_LAS int* tab_, int G_, int c_) { so.init(128 * BM, 8 * BM, G_, c_); tab = tab_; }
    __device__ __forceinline__ bool next(int i, Unit& u) const {
        if (!so.next(i, u)) return false;
        int e = 0;
#pragma unroll
        for (int j = 1; j < 8; ++j) e += (u.pm >= __builtin_amdgcn_readfirstlane(tab[32 + j])) ? 1 : 0;
        u.pn += e * 8; return true;
    }
    __device__ __forceinline__ void a_ready(const Unit&) const {}
    __device__ __forceinline__ void done(const Unit&) const {}
};
struct DownSpillOrder {
    int c, nunits; PG8_LAS int* tab;
    __device__ __forceinline__ void init(PG8_LAS int* tab_, int c_, int ntiles) { c = c_; nunits = (ntiles - 128) * 32; tab = tab_; }
    __device__ __forceinline__ bool next(int i, Unit& u) const {
        if (i != 0 || c >= nunits) return false;
        u.pm = 128 + (c >> 5); int e = 0;
#pragma unroll
        for (int j = 1; j < 8; ++j) e += (u.pm >= __builtin_amdgcn_readfirstlane(tab[32 + j])) ? 1 : 0;
        u.pn = e * 8 + ((c >> 2) & 7); return true;
    }
    __device__ __forceinline__ void a_ready(const Unit&) const {}
    __device__ __forceinline__ void done(const Unit&) const {}
};

struct EpiWin {
    static constexpr bool PERM = true, AFTER_DRAIN = false;
    bf16_t *Q, *K, *V, *BC, *U, *R, *GC; const float *qn, *kn; const float* rowscale; float wsc;
    __device__ __forceinline__ bool zero_after(const Unit&) const { return true; }
    __device__ __forceinline__ void operator()(f32x4 (&acc)[2][2][4][2], const Unit& u, int wr, int wc, int fr, int fq) const {
        const int pn = u.pn; const size_t row0 = (size_t)u.pm * BM + wr * 64 + fr;
        acc_i32_to_f32(acc, rowscale, row0, wsc);
        if (pn < 5) {
            const bool isq = pn < 4; const float* gn = isq ? qn : kn; const float osc = isq ? QSCALE : 1.0f;
            bf16_t* dst = isq ? Q : K; const int ld = isq ? DATT : DKV; const int hcol = (isq ? pn * 4 + wc : wc) * 64 + 8 * fq;
            f32x4 g[2][2];
#pragma unroll
            for (int bj = 0; bj < 2; ++bj)
#pragma unroll
                for (int n = 0; n < 2; ++n) g[bj][n] = *(const f32x4*)(gn + 32 * bj + 8 * fq + 4 * n) * osc;
#pragma unroll
            for (int ai = 0; ai < 2; ++ai)
#pragma unroll
                for (int m = 0; m < 4; ++m) {
                    float ss = 0.f;
#pragma unroll
                    for (int bj = 0; bj < 2; ++bj)
#pragma unroll
                        for (int n = 0; n < 2; ++n) { const f32x4 x = acc[ai][bj][m][n]; ss += (x[0] * x[0] + x[1] * x[1]) + (x[2] * x[2] + x[3] * x[3]); }
                    ss += __shfl_xor(ss, 16); ss += __shfl_xor(ss, 32);
                    const float rinv = 1.0f / sqrtf(ss * (1.0f / 64.0f) + EPS);
                    bf16_t* rowp = dst + (row0 + ai * HALF + m * 16) * ld + hcol;
#pragma unroll
                    for (int bj = 0; bj < 2; ++bj) *(u32x4*)(rowp + 32 * bj) = pack8(acc[ai][bj][m][0] * rinv * g[bj][0], acc[ai][bj][m][1] * rinv * g[bj][1]);
                }
        } else if (pn < 10) {
            const bool isv = pn == 5; bf16_t* dst = isv ? V : BC; const int ld = isv ? DKV : DCONV; const int col0 = (isv ? 0 : (pn - 6) * BM) + wc * 32 + 8 * fq;
#pragma unroll
            for (int ai = 0; ai < 2; ++ai)
#pragma unroll
                for (int m = 0; m < 4; ++m) { bf16_t* rowp = dst + (row0 + ai * HALF + m * 16) * ld + col0;
#pragma unroll
                    for (int bj = 0; bj < 2; ++bj) *(u32x4*)(rowp + bj * HALF) = pack8(acc[ai][bj][m][0], acc[ai][bj][m][1]); }
        } else if (pn < 18) {
            const int col0 = (pn - 10) * HALF + wc * 32 + 8 * fq;
#pragma unroll
            for (int ai = 0; ai < 2; ++ai)
#pragma unroll
                for (int m = 0; m < 4; ++m) *(u32x4*)(U + (row0 + ai * HALF + m * 16) * DCONV + col0) = pack8(acc[ai][0][m][0] * acc[ai][1][m][0], acc[ai][0][m][1] * acc[ai][1][m][1]);
        } else {
            const int col0 = (pn - 18) * HALF + wc * 32 + 8 * fq;
#pragma unroll
            for (int ai = 0; ai < 2; ++ai)
#pragma unroll
                for (int m = 0; m < 4; ++m) { f32x4 rr[2], sc[2];
#pragma unroll
                    for (int n = 0; n < 2; ++n)
#pragma unroll
                        for (int j = 0; j < 4; ++j) { const float ea = 1.0f + fast_exp(-acc[ai][0][m][n][j]); const float ec = 1.0f + fast_exp(-fmaxf(acc[ai][1][m][n][j], -30.0f));
                            const float ia = __builtin_amdgcn_rcpf(ea); rr[n][j] = ec * ia; sc[n][j] = __builtin_amdgcn_rcpf(ec); }
                    const size_t off = (row0 + ai * HALF + m * 16) * D + col0;
                    *(u32x4*)(R + off) = pack8(rr[0], rr[1]); *(u32x4*)(GC + off) = pack8(sc[0], sc[1]); }
        }
    }
};
struct EpiMerge {
    static constexpr bool PERM = true, AFTER_DRAIN = false;
    const bf16_t *R, *GC; bf16_t* MG;
    __device__ __forceinline__ bool zero_after(const Unit& u) const { return u.pm >= 64; }
    __device__ __forceinline__ void operator()(f32x4 (&acc)[2][2][4][2], const Unit& u, int wr, int wc, int fr, int fq) const {
        const bool second = u.pm >= 64; const int pm = u.pm & 63, pn = u.pn & 7;
        const size_t row0 = (size_t)pm * BM + wr * 64 + fr; const int col0 = pn * BM + wc * 32 + 8 * fq;
        const bf16_t* src = second ? GC : R;
#pragma unroll
        for (int ai = 0; ai < 2; ++ai)
#pragma unroll
            for (int m = 0; m < 4; ++m) { const size_t off = (row0 + ai * HALF + m * 16) * D + col0;
#pragma unroll
                for (int bj = 0; bj < 2; ++bj) { f32x4 a, b; unpack8(*(const u32x4*)(src + off + bj * HALF), a, b);
                    acc[ai][bj][m][0] *= a; acc[ai][bj][m][1] *= b;
                    if (second) *(u32x4*)(MG + off + bj * HALF) = pack8(acc[ai][bj][m][0], acc[ai][bj][m][1]); } }
    }
};
template <bool BASE_BF16>
struct EpiResid {
    static constexpr bool PERM = true, AFTER_DRAIN = false;
    const void* base; bf16_t* out; const float* gate;
    __device__ __forceinline__ bool zero_after(const Unit&) const { return true; }
    __device__ __forceinline__ void operator()(f32x4 (&acc)[2][2][4][2], const Unit& u, int wr, int wc, int fr, int fq) const {
        const size_t row0 = (size_t)u.pm * BM + wr * 64 + fr; const int col0 = u.pn * BM + wc * 32 + 8 * fq;
        const float* gp = gate + (size_t)(u.pm >> 4) * MODW + col0;
        f32x4 gv[2][2];
#pragma unroll
        for (int bj = 0; bj < 2; ++bj)
#pragma unroll
            for (int n = 0; n < 2; ++n) gv[bj][n] = *(const f32x4*)(gp + bj * HALF + n * 4);
#pragma unroll
        for (int ai = 0; ai < 2; ++ai)
#pragma unroll
            for (int m = 0; m < 4; ++m) { const size_t off = (row0 + ai * HALF + m * 16) * D + col0;
#pragma unroll
                for (int bj = 0; bj < 2; ++bj) { f32x4 b0, b1;
                    if (BASE_BF16) unpack8(*(const u32x4*)((const bf16_t*)base + off + bj * HALF), b0, b1);
                    else { b0 = *(const f32x4*)((const float*)base + off + bj * HALF); b1 = *(const f32x4*)((const float*)base + off + bj * HALF + 4); }
                    *(u32x4*)(out + off + bj * HALF) = pack8(b0 + gv[bj][0] * acc[ai][bj][m][0], b1 + gv[bj][1] * acc[ai][bj][m][1]); }
                if (m & 1) asm volatile("" ::: "memory"); }
    }
};
struct EpiSwiglu {
    static constexpr bool PERM = true, AFTER_DRAIN = false;
    bf16_t* O; int ld, NT;
    __device__ __forceinline__ bool zero_after(const Unit&) const { return true; }
    __device__ __forceinline__ void operator()(f32x4 (&acc)[2][2][4][2], const Unit& u, int wr, int wc, int fr, int fq) const {
        const size_t row0 = (size_t)u.pm * BM + wr * 64 + fr; const int col0 = (u.pn % NT) * HALF + wc * 32 + 8 * fq;
#pragma unroll
        for (int ai = 0; ai < 2; ++ai)
#pragma unroll
            for (int m = 0; m < 4; ++m) { f32x4 o[2];
#pragma unroll
                for (int n = 0; n < 2; ++n)
#pragma unroll
                    for (int j = 0; j < 4; ++j) { const float g = acc[ai][0][m][n][j]; o[n][j] = g * sigmoid_f(g) * acc[ai][1][m][n][j]; }
                *(u32x4*)(O + (row0 + ai * HALF + m * 16) * ld + col0) = pack8(o[0], o[1]); }
    }
};
struct EpiSwiglu8 {
    static constexpr bool PERM = true, AFTER_DRAIN = false;
    unsigned char* O; int ld, NT; const float* rowscale; float wsc;
    __device__ __forceinline__ bool zero_after(const Unit&) const { return true; }
    __device__ __forceinline__ void operator()(f32x4 (&acc)[2][2][4][2], const Unit& u, int wr, int wc, int fr, int fq) const {
        const size_t row0 = (size_t)u.pm * BM + wr * 64 + fr; const int col0 = (u.pn % NT) * HALF + wc * 32 + 8 * fq;
        acc_i32_to_f32(acc, rowscale, row0, wsc);
#pragma unroll
        for (int ai = 0; ai < 2; ++ai)
#pragma unroll
            for (int m = 0; m < 4; ++m) { f32x4 o[2];
#pragma unroll
                for (int n = 0; n < 2; ++n)
#pragma unroll
                    for (int j = 0; j < 4; ++j) { const float g = acc[ai][0][m][n][j]; o[n][j] = g * sigmoid_f(g) * acc[ai][1][m][n][j] * ACT8_SCALE; }
                typedef unsigned u32x2 __attribute__((ext_vector_type(2)));
                u32x2 w; w.x = pk4_fp8(o[0][0], o[0][1], o[0][2], o[0][3]); w.y = pk4_fp8(o[1][0], o[1][1], o[1][2], o[1][3]);
                *(u32x2*)(O + (row0 + ai * HALF + m * 16) * ld + col0) = w; }
    }
};
struct EpiY {
    static constexpr bool PERM = true, AFTER_DRAIN = false;
    bf16_t* Y; int pm0;
    __device__ __forceinline__ bool zero_after(const Unit&) const { return true; }
    __device__ __forceinline__ void operator()(f32x4 (&acc)[2][2][4][2], const Unit& u, int wr, int wc, int fr, int fq) const {
        const size_t row0 = (size_t)(u.pm - pm0) * BM + wr * 64 + fr; const int col0 = (u.pn & 7) * BM + wc * 32 + 8 * fq;
#pragma unroll
        for (int ai = 0; ai < 2; ++ai)
#pragma unroll
            for (int m = 0; m < 4; ++m) { bf16_t* rowp = Y + (row0 + ai * HALF + m * 16) * D + col0;
#pragma unroll
                for (int bj = 0; bj < 2; ++bj) *(u32x4*)(rowp + bj * HALF) = pack8(acc[ai][bj][m][0], acc[ai][bj][m][1]); }
    }
};

template <class Epi, class Sched, bool ALIGN_EPI = false, bool SP2 = false, int MODE = 0  >
__device__ __forceinline__ void gemm_phase(PG8_LAS unsigned char* lds, const Gemm g, const Sched& S, const Epi& E) {
    constexpr bool FP8 = (MODE == 1), I8 = (MODE == 2);
    const int tid = threadIdx.x, wid = __builtin_amdgcn_readfirstlane(tid >> 6), lane = tid & 63, wr = wid >> 2, wc = wid & 3, fr = lane & 15, fq = lane >> 4;
    const int K = g.K, nt = (g.Kloop ? g.Kloop : K) / BK;
    unsigned voffA[2], voffB[2];
#pragma unroll
    for (int i = 0; i < 2; ++i) { int R, C; stage_rc(tid * 16 + i * 8192, R, C); const int Rb = Epi::PERM ? ((R & ~31) + perm32(R & 31)) : R;
        voffA[i] = (unsigned)(R * K + C) * 2u; voffB[i] = (unsigned)(Rb * K + C) * 2u; }
    const size_t kstep = (size_t)(BK * 2);
    const size_t hstep = (size_t)HALF * K * 2;
    const size_t tstep = 2 * hstep;
    const unsigned ldsw = (unsigned)wid * 1024u;
    const int aoff = lds_byte(wr * 64 + fr, fq * 8), boff = lds_byte(wc * 32 + fr, fq * 8);
#define PG8_SA(b, h) (((b) * 2 + (h)) * HTB)
#define PG8_SB(b, h) ((4 + (b) * 2 + (h)) * HTB)
#define PG8_STAGE(bufoff, gbase, voff) do { _Pragma("unroll") for (int _i = 0; _i < 2; ++_i) \
        __builtin_amdgcn_global_load_lds((const unsigned*)((const char*)(gbase) + (voff)[_i]), (PG8_LAS unsigned*)(lds + (bufoff) + ldsw + _i * 8192), 16, 0, 0); } while (0)
#define PG8_LDA(dst, b, h) do { _Pragma("unroll") for (int m = 0; m < 4; ++m) { if constexpr (FP8) dst##8[m] = __builtin_shufflevector(*(const PG8_LAS v4i*)(lds + PG8_SA(b, h) + aoff + m * 2048), *(const PG8_LAS v4i*)(lds + PG8_SA(b, h) + aoff + m * 2048 + 1024), 0, 1, 2, 3, 4, 5, 6, 7); \
        else { _Pragma("unroll") for (int k = 0; k < 2; ++k) dst[m][k] = *(const PG8_LAS bf16x8*)(lds + PG8_SA(b, h) + aoff + m * 2048 + k * 1024); } } } while (0)
#define PG8_LDB(dst, b, h) do { _Pragma("unroll") for (int n = 0; n < 2; ++n) { if constexpr (FP8) dst##8[n] = __builtin_shufflevector(*(const PG8_LAS v4i*)(lds + PG8_SB(b, h) + boff + n * 2048), *(const PG8_LAS v4i*)(lds + PG8_SB(b, h) + boff + n * 2048 + 1024), 0, 1, 2, 3, 4, 5, 6, 7); \
        else { _Pragma("unroll") for (int k = 0; k < 2; ++k) dst[n][k] = *(const PG8_LAS bf16x8*)(lds + PG8_SB(b, h) + boff + n * 2048 + k * 1024); } } } while (0)
#define PG8_MMA(ai, bj, At, Bt) do { __builtin_amdgcn_s_setprio(1); \
        if constexpr (FP8) { _Pragma("unroll") for (int m = 0; m < 4; ++m) _Pragma("unroll") for (int n = 0; n < 2; ++n) \
            asm volatile("v_mfma_scale_f32_16x16x128_f8f6f4 %0, %1, %2, %0, %3, %4 op_sel:[0,0,0] op_sel_hi:[0,0,0]" : "+v"(acc[ai][bj][m][n]) : "v"(Bt##8[n]), "v"(At##8[m]), "v"(scaleB8), "v"(scaleA8)); } \
        else if constexpr (I8) { _Pragma("unroll") for (int m = 0; m < 4; ++m) _Pragma("unroll") for (int n = 0; n < 2; ++n) _Pragma("unroll") for (int k = 0; k < 2; ++k) \
            acc[ai][bj][m][n] = __builtin_bit_cast(f32x4, __builtin_amdgcn_mfma_i32_16x16x64_i8(__builtin_bit_cast(v4i, Bt[n][k]), __builtin_bit_cast(v4i, At[m][k]), __builtin_bit_cast(v4i, acc[ai][bj][m][n]), 0, 0, 0)); } \
        else { _Pragma("unroll") for (int m = 0; m < 4; ++m) _Pragma("unroll") for (int n = 0; n < 2; ++n) _Pragma("unroll") for (int k = 0; k < 2; ++k) \
            acc[ai][bj][m][n] = __builtin_amdgcn_mfma_f32_16x16x32_bf16(Bt[n][k], At[m][k], acc[ai][bj][m][n], 0, 0, 0); } \
        __builtin_amdgcn_s_setprio(0); } while (0)
#define PG8_WAIT_V(n) asm volatile("s_waitcnt vmcnt(" #n ")" ::: "memory")
#define PG8_WAIT_L(n) asm volatile("s_waitcnt lgkmcnt(" #n ")" ::: "memory")
#define PG8_BAR __builtin_amdgcn_s_barrier()
#define PG8_SCHED __builtin_amdgcn_sched_barrier(0)
    Unit cur, nxt; int ui = 0;
    if (!S.next(0, cur)) return;
    f32x4 acc[2][2][4][2];
#pragma unroll
    for (int a = 0; a < 2; ++a)
#pragma unroll
        for (int b = 0; b < 2; ++b)
#pragma unroll
            for (int m = 0; m < 4; ++m)
#pragma unroll
                for (int n = 0; n < 2; ++n) acc[a][b][m][n] = (f32x4){0.f, 0.f, 0.f, 0.f};
    const int scaleB8 = (g.sB & 0xff) * 0x01010101, scaleA8 = ((g.sB >> 8) & 0xff) * 0x01010101;
    bf16x8 At[4][2], B0[2][2], B1[2][2]; v8i At8[4], B08[2], B18[2];
    const char* cA = (const char*)g.A + (size_t)cur.pm * tstep; const char* cB = (const char*)g.Bt + (size_t)cur.pn * tstep;
    S.a_ready(cur);
    if constexpr (SP2) {
        PG8_STAGE(PG8_SB(0, 0), cB, voffB); PG8_STAGE(PG8_SB(0, 1), cB + hstep, voffB); PG8_STAGE(PG8_SA(0, 0), cA, voffA); PG8_STAGE(PG8_SA(0, 1), cA + hstep, voffA);
        if (wr == 1) PG8_BAR;
        PG8_WAIT_V(2); PG8_BAR;
        PG8_STAGE(PG8_SB(1, 0), cB + kstep, voffB); PG8_STAGE(PG8_SA(1, 0), cA + kstep, voffA); PG8_STAGE(PG8_SB(1, 1), cB + hstep + kstep, voffB);
        PG8_WAIT_V(6); PG8_BAR;
    } else {
        PG8_STAGE(PG8_SB(0, 0), cB, voffB); PG8_STAGE(PG8_SA(0, 0), cA, voffA); PG8_STAGE(PG8_SB(0, 1), cB + hstep, voffB); PG8_STAGE(PG8_SA(0, 1), cA + hstep, voffA);
        if (wr == 1) PG8_BAR;
        PG8_WAIT_V(4); PG8_BAR;
        PG8_STAGE(PG8_SB(1, 0), cB + kstep, voffB); PG8_STAGE(PG8_SA(1, 0), cA + kstep, voffA); PG8_STAGE(PG8_SB(1, 1), cB + hstep + kstep, voffB);
        PG8_WAIT_V(6); PG8_BAR;
    }
    for (;;) {
        const bool has_next = S.next(ui + 1, nxt);
        const char* nA = has_next ? (const char*)g.A + (size_t)nxt.pm * tstep : cA; const char* nB = has_next ? (const char*)g.Bt + (size_t)nxt.pn * tstep : cB;
        for (int t = 0; t < nt; t += 2) {
            const bool last = (t == nt - 2);
            const char* a1 = cA + (size_t)(t + 1) * kstep;
            const char* a2 = last ? nA : cA + (size_t)(t + 2) * kstep; const char* b2 = last ? nB : cB + (size_t)(t + 2) * kstep;
            const char* a3 = a2 + kstep; const char* b3 = b2 + kstep;
            if (last && has_next) S.a_ready(nxt);
            if constexpr (SP2) {
            PG8_LDB(B0, 0, 0); PG8_LDB(B1, 0, 1); PG8_SCHED; PG8_LDA(At, 0, 0); PG8_STAGE(PG8_SA(1, 1), a1 + hstep, voffA);
            PG8_WAIT_V(8); PG8_WAIT_L(0); PG8_BAR; PG8_MMA(0, 0, At, B0); PG8_MMA(0, 1, At, B1); PG8_BAR; PG8_SCHED;
            PG8_LDA(At, 0, 1); PG8_STAGE(PG8_SB(0, 0), b2, voffB); PG8_STAGE(PG8_SB(0, 1), b2 + hstep, voffB); PG8_STAGE(PG8_SA(0, 0), a2, voffA);
            PG8_WAIT_V(8); PG8_WAIT_L(0); PG8_BAR; PG8_MMA(1, 0, At, B0); PG8_MMA(1, 1, At, B1); PG8_BAR; PG8_SCHED;
            PG8_LDB(B0, 1, 0); PG8_LDB(B1, 1, 1); PG8_SCHED; PG8_LDA(At, 1, 0); PG8_STAGE(PG8_SA(0, 1), a2 + hstep, voffA);
            PG8_WAIT_V(8); PG8_WAIT_L(0); PG8_BAR; PG8_MMA(0, 0, At, B0); PG8_MMA(0, 1, At, B1); PG8_BAR; PG8_SCHED;
            PG8_LDA(At, 1, 1); PG8_STAGE(PG8_SB(1, 0), b3, voffB); PG8_STAGE(PG8_SB(1, 1), b3 + hstep, voffB); PG8_STAGE(PG8_SA(1, 0), a3, voffA);
            PG8_WAIT_V(8); PG8_WAIT_L(0); PG8_BAR; PG8_MMA(1, 0, At, B0); PG8_MMA(1, 1, At, B1); PG8_BAR; PG8_SCHED;
            } else {
            PG8_LDB(B0, 0, 0); PG8_SCHED; PG8_LDA(At, 0, 0); PG8_STAGE(PG8_SA(1, 1), a1 + hstep, voffA);
            PG8_WAIT_L(8); PG8_BAR; PG8_WAIT_L(0); PG8_MMA(0, 0, At, B0); PG8_BAR; PG8_SCHED;
            PG8_LDB(B1, 0, 1); PG8_STAGE(PG8_SB(0, 0), b2, voffB);
            PG8_BAR; PG8_WAIT_L(0); PG8_MMA(0, 1, At, B1); PG8_BAR;
            PG8_LDA(At, 0, 1); PG8_STAGE(PG8_SA(0, 0), a2, voffA);
            PG8_BAR; PG8_WAIT_L(0); PG8_MMA(1, 0, At, B0); PG8_BAR; PG8_SCHED;
            PG8_STAGE(PG8_SB(0, 1), b2 + hstep, voffB);
            PG8_WAIT_V(6); PG8_BAR; PG8_MMA(1, 1, At, B1); PG8_BAR;
            PG8_LDB(B0, 1, 0); PG8_SCHED; PG8_LDA(At, 1, 0); PG8_STAGE(PG8_SA(0, 1), a2 + hstep, voffA);
            PG8_WAIT_L(8); PG8_BAR; PG8_WAIT_L(0); PG8_MMA(0, 0, At, B0); PG8_BAR; PG8_SCHED;
            PG8_LDB(B1, 1, 1); PG8_STAGE(PG8_SB(1, 0), b3, voffB);
            PG8_BAR; PG8_WAIT_L(0); PG8_MMA(0, 1, At, B1); PG8_BAR;
            PG8_LDA(At, 1, 1); PG8_STAGE(PG8_SA(1, 0), a3, voffA);
            PG8_BAR; PG8_WAIT_L(0); PG8_MMA(1, 0, At, B0); PG8_BAR; PG8_SCHED;
            PG8_STAGE(PG8_SB(1, 1), b3 + hstep, voffB);
            PG8_WAIT_V(6); PG8_BAR; PG8_MMA(1, 1, At, B1); PG8_BAR;
            }
        }
        if constexpr (FP8) asm volatile("s_nop 15\n\ts_nop 15" ::: "memory");
        if constexpr (ALIGN_EPI) { if (wr == 0) PG8_BAR; }
        if constexpr (!Epi::AFTER_DRAIN) { E(acc, cur, wr, wc, fr, fq); S.done(cur); }
        if (!has_next) break;
        if (E.zero_after(cur)) {
#pragma unroll
        for (int a = 0; a < 2; ++a)
#pragma unroll
            for (int b = 0; b < 2; ++b)
#pragma unroll
                for (int m = 0; m < 4; ++m)
#pragma unroll
                    for (int n = 0; n < 2; ++n) acc[a][b][m][n] = (f32x4){0.f, 0.f, 0.f, 0.f}; }
        cur = nxt; cA = nA; cB = nB; ++ui;
        if constexpr (ALIGN_EPI) { if (wr == 1) PG8_BAR; }
    }
    PG8_WAIT_V(0);
    if constexpr (!ALIGN_EPI) { if (wr == 0) PG8_BAR; }
    PG8_BAR;
    if constexpr (Epi::AFTER_DRAIN) { E.fused(acc, cur, wr, wc, fr, fq, lds, wid, lane); S.done(cur); }
#undef PG8_SA
#undef PG8_SB
#undef PG8_STAGE
#undef PG8_LDA
#undef PG8_LDB
#undef PG8_MMA
#undef PG8_WAIT_V
#undef PG8_WAIT_L
#undef PG8_BAR
#undef PG8_SCHED
}
}
#define XB_TMO      128
#define XB_XCNT(j)  (256  + 64 * (j))
#define XB_XSUB(j)  (1280 + 64 * (j))
#define XB_XGEN(j)  (2304 + 64 * (j))
#define XB_TOP      3328
#define XB_TOPGEN   3392
#define XCD_BAR_WORDS 3456
#define XB_SPIN_CAP (1u << 18)

__device__ __forceinline__ unsigned xb_ld(unsigned* p)              { return __hip_atomic_load(p, __ATOMIC_RELAXED, __HIP_MEMORY_SCOPE_AGENT); }
__device__ __forceinline__ unsigned xb_add(unsigned* p, unsigned v) { return __hip_atomic_fetch_add(p, v, __ATOMIC_RELAXED, __HIP_MEMORY_SCOPE_AGENT); }
__device__ __forceinline__ unsigned xb_xcc_id() { return (unsigned)__builtin_amdgcn_s_getreg((3 << 11) | 20) & 0xFu; }
#define XB_SPIN(cond, bar) do { unsigned _sp = 0; while (cond) { __builtin_amdgcn_s_sleep(1); \
    if ((++_sp & 255u) == 0u) { if (xb_ld(&(bar)[XB_TMO])) break; if (_sp > XB_SPIN_CAP) { atomicAdd(&(bar)[XB_TMO], 1u); break; } } } } while (0)

struct XcdBarrier {
    unsigned* bar; unsigned x;
    volatile LAS unsigned* st;
};

__device__ __forceinline__ XcdBarrier xcd_barrier_post(unsigned* bar, volatile LAS unsigned* st) {
    XcdBarrier b; b.bar = bar; b.x = xb_xcc_id(); b.st = st;
    if (threadIdx.x == 0) (void)xb_add(&bar[XB_XCNT(b.x)], 1u);
    return b;
}
__device__ __forceinline__ void xcd_barrier_complete(unsigned* bar, unsigned x, unsigned& nloc, unsigned& nx) {
    const unsigned G = gridDim.x * gridDim.y * gridDim.z;
    unsigned sum, cnt, mine, sp = 0u;
    for (;;) {
        sum = 0u; cnt = 0u; mine = 0u;
#pragma unroll
        for (unsigned j = 0; j < 16; ++j) { const unsigned c = xb_ld(&bar[XB_XCNT(j)]); sum += c; cnt += (c > 0u) ? 1u : 0u; mine = (j == x) ? c : mine; }
        if (sum == G) break;
        __builtin_amdgcn_s_sleep(1);
        if ((++sp & 255u) == 0u) { if (xb_ld(&bar[XB_TMO])) break; if (sp > XB_SPIN_CAP) { atomicAdd(&bar[XB_TMO], 1u); break; } }
    }
    nloc = mine > 0u ? mine : 1u; nx = cnt > 0u ? cnt : 1u;
}

__device__ __forceinline__ void xcd_barrier(const XcdBarrier& b) {
    asm volatile("s_waitcnt vmcnt(0)" ::: "memory");
    __syncthreads();
    if (threadIdx.x == 0) {
        unsigned* bar = b.bar;
        __builtin_amdgcn_s_waitcnt(0);
        unsigned nloc = b.st[0], nx = b.st[1];
        if (nloc == 0u) { xcd_barrier_complete(bar, b.x, nloc, nx); b.st[0] = nloc; b.st[1] = nx; }
        const unsigned old = xb_add(&bar[XB_XSUB(b.x)], 1u);
        const unsigned gen = old / nloc;
        if (old + 1u == (gen + 1u) * nloc) {
            __builtin_amdgcn_fence(__ATOMIC_RELEASE, "agent");
            asm volatile("s_waitcnt vmcnt(0)" ::: "memory");
            const unsigned og = xb_add(&bar[XB_TOP], 1u);
            const unsigned tg = og / nx;
            if (og + 1u == (tg + 1u) * nx) xb_add(&bar[XB_TOPGEN], 1u);
            else XB_SPIN(xb_ld(&bar[XB_TOPGEN]) == tg, bar);
            __builtin_amdgcn_fence(__ATOMIC_ACQUIRE, "agent");
            xb_add(&bar[XB_XGEN(b.x)], 1u);
            asm volatile("s_waitcnt vmcnt(0)" ::: "memory");
        } else {
            XB_SPIN(xb_ld(&bar[XB_XGEN(b.x)]) == gen, bar);
            __builtin_amdgcn_fence(__ATOMIC_ACQUIRE, "agent");
            asm volatile("s_waitcnt vmcnt(0)" ::: "memory");
        }
    }
    __syncthreads();
}

typedef pg8::bf16_t bf16_t;
typedef pg8::f32x4 f32x4;
typedef pg8::bf16x8 bf16x8;
__device__ __forceinline__ unsigned f2bf(float f) { unsigned u = __builtin_bit_cast(unsigned, f); return (u + 0x7fffu + ((u >> 16) & 1u)) >> 16; }
__device__ __forceinline__ unsigned pk2(float lo, float hi) { return f2bf(lo) | (f2bf(hi) << 16); }
__device__ __forceinline__ float wave_sum(float v) {
#pragma unroll
    for (int o = 1; o < 64; o <<= 1) v += __shfl_xor(v, o);
    return v;
}
__device__ __forceinline__ void lds_add(LAS int* p, int v) { (void)__hip_atomic_fetch_add(p, v, __ATOMIC_RELAXED, __HIP_MEMORY_SCOPE_WORKGROUP); }
__device__ __forceinline__ float bf_lo(unsigned w) { return __uint_as_float(w << 16); }
__device__ __forceinline__ float bf_hi(unsigned w) { return __uint_as_float(w & 0xffff0000u); }

__device__ __forceinline__ void p0_mod(LAS unsigned char* lds, const float* cvec, const float* ada_w, const float* ada_b, float* MOD, int G) {
    LAS float* sc = (LAS float*)lds;
    LAS float* red = (LAS float*)(lds + 32768);
    const int tid = threadIdx.x, lane = tid & 63, wave = tid >> 6;
    for (int i = tid; i < NBATCH * D; i += 512) { const float v = cvec[i]; sc[i] = v / (1.0f + __expf(-v)); }
    __syncthreads();
    for (int it = blockIdx.x; it < 2 * (MODW / 32); it += G) {
        const int l = it / (MODW / 32), n0 = (it % (MODW / 32)) * 32, kp = lane >> 3, cq = lane & 7;
        const GAS f32x4* W = (const GAS f32x4*)(ada_w + (size_t)l * D * MODW + n0 + 4 * cq);
        f32x4 a0 = {0.f, 0.f, 0.f, 0.f}, a1 = a0, a2 = a0, a3 = a0;
        const int k0 = wave * 256 + kp;
        for (int kk = k0; kk < k0 + 256; kk += 128) {
            f32x4 w[16];
#pragma unroll
            for (int u = 0; u < 16; ++u) w[u] = W[(size_t)(kk + 8 * u) * (MODW / 4)];
#pragma unroll
            for (int u = 0; u < 16; ++u) { const int k = kk + 8 * u; a0 += w[u] * sc[k]; a1 += w[u] * sc[D + k]; a2 += w[u] * sc[2 * D + k]; a3 += w[u] * sc[3 * D + k]; }
        }
#pragma unroll
        for (int o = 8; o < 64; o <<= 1) {
#pragma unroll
            for (int c = 0; c < 4; ++c) { a0[c] += __shfl_xor(a0[c], o); a1[c] += __shfl_xor(a1[c], o); a2[c] += __shfl_xor(a2[c], o); a3[c] += __shfl_xor(a3[c], o); } }
        if (lane < 8) { *(LAS f32x4*)(red + (wave * 4 + 0) * 32 + 4 * lane) = a0; *(LAS f32x4*)(red + (wave * 4 + 1) * 32 + 4 * lane) = a1; *(LAS f32x4*)(red + (wave * 4 + 2) * 32 + 4 * lane) = a2; *(LAS f32x4*)(red + (wave * 4 + 3) * 32 + 4 * lane) = a3; }
        __syncthreads();
        if (wave < 4 && lane < 32) { float s = 0.f;
#pragma unroll
            for (int w2 = 0; w2 < 8; ++w2) s += red[(w2 * 4 + wave) * 32 + lane];
            MOD[(size_t)(l * NBATCH + wave) * MODW + n0 + lane] = s + ada_b[l * MODW + n0 + lane]; }
        __syncthreads();
    }
}
__device__ __forceinline__ int win_src_col(int dg) {
    const int pn = dg >> 3, wi = dg & 7;
    if (pn < 5) return 256 * pn + 64 * (wi & 3) + 32 * (wi >> 2);
    if (pn < 10) return 32 * dg;
    if (pn < 18) return 2560 + (wi >> 2) * 1024 + (pn - 10) * 128 + (wi & 3) * 32;
    return 4608 + (wi >> 2) * 2048 + (pn - 18) * 128 + (wi & 3) * 32;
}
__device__ __forceinline__ int gu_src_col(int dg, int F) { const int pn = dg >> 3, wi = dg & 7; return (wi >> 2) * F + pn * 128 + (wi & 3) * 32; }

struct Wts { const float *w_in, *w_ab, *w_cb, *w_out, *ffn_gu, *ffn_dn, *moe_gu, *moe_dn; bf16_t *WAC, *WOUT; unsigned char *WIN, *WGU, *WDN, *MGU, *MDN; };
struct TrDesc { const float* src; unsigned char* dst; int N, pitch, mode; float scale; };
__device__ __forceinline__ TrDesc tr_decode(const Wts& w, int it) {
    constexpr int I_WIN = (D / 64) * (DIN / 32), I_AC = (DATT / 64) * (D / 32), I_OUT = (D / 64) * (D / 32), I_GU = (D / 64) * (2 * DFF / 32), I_DN = (DFF / 64) * (D / 32),
                  I_MGU = (D / 64) * (2 * MFF / 32), I_MDN = (MFF / 64) * (D / 32);
    TrDesc d; int r = it;
    if (r < 2 * I_WIN) { const int l = r / I_WIN, rr = r % I_WIN, kb = rr % (D / 64), dg = rr / (D / 64);
        d.src = w.w_in + (size_t)l * D * DIN + (size_t)(64 * kb) * DIN + win_src_col(dg); d.N = DIN; d.pitch = D; d.mode = 2; d.scale = W8I_SCALE; d.dst = w.WIN + (size_t)l * DIN * D + (size_t)(32 * dg) * D + 64 * kb; return d; }
    r -= 2 * I_WIN;
    if (r < 4 * I_AC) { const int mi = r / I_AC, rr = r % I_AC, l = mi >> 1, which = mi & 1, kb = rr % (DATT / 64), dg = rr / (DATT / 64);
        d.src = (which ? w.w_cb : w.w_ab) + (size_t)l * DATT * D + (size_t)(64 * kb) * D + 32 * dg; d.N = D; d.pitch = DATT * 2; d.mode = 0; d.scale = 1.0f; d.dst = (unsigned char*)(w.WAC + (size_t)mi * D * DATT + (size_t)(32 * dg) * DATT + 64 * kb); return d; }
    r -= 4 * I_AC;
    if (r < 2 * I_OUT) { const int l = r / I_OUT, rr = r % I_OUT, kb = rr % (D / 64), dg = rr / (D / 64);
        d.src = w.w_out + (size_t)l * D * D + (size_t)(64 * kb) * D + 32 * dg; d.N = D; d.pitch = D * 2; d.mode = 0; d.scale = 1.0f; d.dst = (unsigned char*)(w.WOUT + (size_t)l * D * D + (size_t)(32 * dg) * D + 64 * kb); return d; }
    r -= 2 * I_OUT;
    if (r < I_GU) { const int kb = r % (D / 64), dg = r / (D / 64);
        d.src = w.ffn_gu + (size_t)(64 * kb) * (2 * DFF) + gu_src_col(dg, DFF); d.N = 2 * DFF; d.pitch = D; d.mode = 2; d.scale = W8I_SCALE; d.dst = w.WGU + (size_t)(32 * dg) * D + 64 * kb; return d; }
    r -= I_GU;
    if (r < I_DN) { const int kb = r % (DFF / 64), dg = r / (DFF / 64);
        d.src = w.ffn_dn + (size_t)(64 * kb) * D + 32 * dg; d.N = D; d.pitch = DFF; d.mode = 1; d.scale = (float)(1 << MDN8_LOG2); d.dst = w.WDN + (size_t)(32 * dg) * DFF + 64 * kb; return d; }
    r -= I_DN;
    if (r < NEXP * I_MGU) { const int e = r / I_MGU, rr = r % I_MGU, kb = rr % (D / 64), dg = rr / (D / 64);
        d.src = w.moe_gu + (size_t)e * D * 2 * MFF + (size_t)(64 * kb) * (2 * MFF) + gu_src_col(dg, MFF); d.N = 2 * MFF; d.pitch = D; d.mode = 2; d.scale = W8I_SCALE; d.dst = w.MGU + (size_t)e * 2 * MFF * D + (size_t)(32 * dg) * D + 64 * kb; return d; }
    r -= NEXP * I_MGU;
    { const int e = r / I_MDN, rr = r % I_MDN, kb = rr % (MFF / 64), dg = rr / (MFF / 64);
        d.src = w.moe_dn + (size_t)e * MFF * D + (size_t)(64 * kb) * D + 32 * dg; d.N = D; d.pitch = MFF; d.mode = 1; d.scale = (float)(1 << MDN8_LOG2); d.dst = w.MDN + (size_t)e * D * MFF + (size_t)(32 * dg) * MFF + 64 * kb; return d; }
}
__device__ __forceinline__ void tr_load(const TrDesc& d, int lane, f32x4 (&a)[8]) {
    const GAS f32x4* src = (const GAS f32x4*)(d.src + (size_t)(8 * (lane >> 3)) * d.N + 4 * (lane & 7));
#pragma unroll
    for (int i = 0; i < 8; ++i) a[i] = src[(size_t)i * (d.N / 4)];
}
__device__ __forceinline__ void tr_store(const TrDesc& d, int lane, const f32x4 (&a)[8]) {
    const int kb = lane >> 3, nq = lane & 7;
#pragma unroll
    for (int c = 0; c < 4; ++c) {
        unsigned char* p = d.dst + (size_t)(4 * nq + c) * d.pitch;
        if (d.mode == 0) { v4u o; o.x = pk2(a[0][c], a[1][c]); o.y = pk2(a[2][c], a[3][c]); o.z = pk2(a[4][c], a[5][c]); o.w = pk2(a[6][c], a[7][c]); *(GAS v4u*)(p + 16 * kb) = o; }
        else { v2u o; const float sc = d.scale;
            if (d.mode == 2) { o.x = pg8::pk4_i8(a[0][c] * sc, a[1][c] * sc, a[2][c] * sc, a[3][c] * sc); o.y = pg8::pk4_i8(a[4][c] * sc, a[5][c] * sc, a[6][c] * sc, a[7][c] * sc); }
            else { o.x = pg8::pk4_fp8(a[0][c] * sc, a[1][c] * sc, a[2][c] * sc, a[3][c] * sc); o.y = pg8::pk4_fp8(a[4][c] * sc, a[5][c] * sc, a[6][c] * sc, a[7][c] * sc); }
            *(GAS v2u*)(p + 8 * kb) = o; }
    }
}
__device__ __forceinline__ void p0_convert(LAS unsigned char* lds, const Wts& w, int vcu, int G) {
    const int lane = threadIdx.x & 63, wave = threadIdx.x >> 6;
    const int gw = vcu * 8 + wave, NGW = G * 8;
    constexpr int NITEMS = (D / 64) * (DIN / 32);
    static_assert(NITEMS % 2 == 0, "items come in k-block pairs");
    int it = 2 * gw; if (it >= NITEMS) return;
    TrDesc p0 = tr_decode(w, it), p1 = tr_decode(w, it + 1), q0 = p0, q1 = p1; f32x4 a0[8], a1[8], b0[8], b1[8];
    tr_load(p0, lane, a0); tr_load(p1, lane, a1);
    for (;;) {
        it += 2 * NGW; const bool hq = it < NITEMS;
        if (hq) { q0 = tr_decode(w, it); q1 = tr_decode(w, it + 1); tr_load(q0, lane, b0); tr_load(q1, lane, b1); }
        tr_store(p0, lane, a0); tr_store(p1, lane, a1);
        if (!hq) break;
        it += 2 * NGW; const bool hp = it < NITEMS;
        if (hp) { p0 = tr_decode(w, it); p1 = tr_decode(w, it + 1); tr_load(p0, lane, a0); tr_load(p1, lane, a1); }
        tr_store(q0, lane, b0); tr_store(q1, lane, b1);
        if (!hp) break;
    }
}

struct TileDesc { const float* src; unsigned char* dst; int N, pitch, hstride, mode; float scale; int pg0 = -1; };
__device__ __forceinline__ TileDesc tile_decode(const Wts& w, int t) {
    constexpr int T_GU = (D / 128) * (2 * DFF / 256), T_DN = (DFF / 128) * (D / 256), T_MGU = (D / 128) * (2 * MFF / 256), T_MDN = (MFF / 128) * (D / 256);
    TileDesc d; int r = t;
    if (r < T_GU) { const int kt = r % (D / 128), ct = r / (D / 128), col0 = 256 * ct, up = col0 >= DFF ? 1 : 0, j = (col0 - up * DFF) / 256;
        d.src = w.ffn_gu + (size_t)(128 * kt) * (2 * DFF) + col0; d.N = 2 * DFF; d.pitch = D; d.hstride = 256; d.mode = 2; d.scale = W8I_SCALE; d.dst = w.WGU + (size_t)(512 * j + 128 * up) * D + 128 * kt; return d; }
    r -= T_GU;
    if (r < T_DN) { const int kt = r % (DFF / 128), ct = r / (DFF / 128);
        d.src = w.ffn_dn + (size_t)(128 * kt) * D + 256 * ct; d.N = D; d.pitch = DFF; d.hstride = 128; d.mode = 1; d.scale = (float)(1 << MDN8_LOG2); d.dst = w.WDN + (size_t)(256 * ct) * DFF + 128 * kt; return d; }
    r -= T_DN;
    if (r < NEXP * T_MGU) { const int e = r / T_MGU, rr = r % T_MGU, kt = rr % (D / 128), ct = rr / (D / 128), col0 = 256 * ct, up = col0 >= MFF ? 1 : 0, j = (col0 - up * MFF) / 256;
        d.src = w.moe_gu + (size_t)e * D * 2 * MFF + (size_t)(128 * kt) * (2 * MFF) + col0; d.N = 2 * MFF; d.pitch = D; d.hstride = 256; d.mode = 2; d.scale = W8I_SCALE;
        d.dst = w.MGU + (size_t)e * 2 * MFF * D + (size_t)(512 * j + 128 * up) * D + 128 * kt; return d; }
    r -= NEXP * T_MGU;
    { const int e = r / T_MDN, rr = r % T_MDN, kt = rr % (MFF / 128), ct = rr / (MFF / 128);
        d.src = w.moe_dn + (size_t)e * MFF * D + (size_t)(128 * kt) * D + 256 * ct; d.N = D; d.pitch = MFF; d.hstride = 128; d.mode = 1; d.scale = (float)(1 << MDN8_LOG2);
        d.dst = w.MDN + (size_t)e * D * MFF + (size_t)(256 * ct) * MFF + 128 * kt; return d; }
}
__device__ __forceinline__ void tile_load(const TileDesc& d, int wave, int lane, f32x4 (&a)[16]) {
    const bool half = d.mode == 0;
    const GAS f32x4* src = (const GAS f32x4*)(d.src + (size_t)((half ? 8 : 16) * wave) * d.N + 4 * lane);
#pragma unroll
    for (int i = 0; i < 8; ++i) a[i] = src[(size_t)i * (d.N / 4)];
    if (!half) {
#pragma unroll
        for (int i = 8; i < 16; ++i) a[i] = src[(size_t)i * (d.N / 4)];
    } else {
#pragma unroll
        for (int i = 8; i < 16; ++i) a[i] = (f32x4){0.f, 0.f, 0.f, 0.f};
    }
}
__device__ __forceinline__ int win_dst_group(int sg) {
    if (sg < 40) { const int pn = sg >> 3, l = sg & 7; return 8 * pn + (l >> 1) + 4 * (l & 1); }
    if (sg < 80) return sg;
    if (sg < 144) { const int c = (sg - 80) * 32, hf = c >= 1024 ? 1 : 0, o = c - hf * 1024; return 8 * (10 + o / 128) + hf * 4 + (o % 128) / 32; }
    const int c = (sg - 144) * 32, hf = c >= 2048 ? 1 : 0, o = c - hf * 2048; return 8 * (18 + o / 128) + hf * 4 + (o % 128) / 32;
}
__device__ __forceinline__ void tile_to_lds(const TileDesc& d, LAS unsigned char* buf, int wave, int lane, const f32x4 (&a)[16]) {
    const float sc = d.scale;
#pragma unroll
    for (int c = 0; c < 4; ++c) {
        v4u o;
        if (d.mode == 0) { o.x = pk2(a[0][c], a[1][c]); o.y = pk2(a[2][c], a[3][c]); o.z = pk2(a[4][c], a[5][c]); o.w = pk2(a[6][c], a[7][c]); }
        else if (d.mode == 2) { o.x = pg8::pk4_i8(a[0][c] * sc, a[1][c] * sc, a[2][c] * sc, a[3][c] * sc); o.y = pg8::pk4_i8(a[4][c] * sc, a[5][c] * sc, a[6][c] * sc, a[7][c] * sc);
                           o.z = pg8::pk4_i8(a[8][c] * sc, a[9][c] * sc, a[10][c] * sc, a[11][c] * sc); o.w = pg8::pk4_i8(a[12][c] * sc, a[13][c] * sc, a[14][c] * sc, a[15][c] * sc); }
        else { o.x = pg8::pk4_fp8(a[0][c] * sc, a[1][c] * sc, a[2][c] * sc, a[3][c] * sc); o.y = pg8::pk4_fp8(a[4][c] * sc, a[5][c] * sc, a[6][c] * sc, a[7][c] * sc);
               o.z = pg8::pk4_fp8(a[8][c] * sc, a[9][c] * sc, a[10][c] * sc, a[11][c] * sc); o.w = pg8::pk4_fp8(a[12][c] * sc, a[13][c] * sc, a[14][c] * sc, a[15][c] * sc); }
        const int n = 4 * lane + c, pos = (((n & 1) << 3) + wave) ^ (lane & 15);
        *(LAS v4u*)(buf + (n >> 1) * 256 + 16 * pos) = o;
    }
}
__device__ __forceinline__ void tile_store(const TileDesc& d, const LAS unsigned char* buf, int tid) {
#pragma unroll
    for (int j = 0; j < 4; ++j) {
        const int row = j * 64 + (tid >> 3), ch = tid & 7, pos = (((row & 1) << 3) + ch) ^ ((row >> 2) & 15);
        const v4u v = *(const LAS v4u*)(buf + (row >> 1) * 256 + 16 * pos);
        const int drow = d.pg0 >= 0 ? 32 * win_dst_group(d.pg0 + (row >> 5)) + (row & 31) : (row >> 7) * d.hstride + (row & 127);
        *(GAS v4u*)(d.dst + (size_t)drow * d.pitch + 16 * ch) = v;
    }
}
constexpr int NT_FFN = (D / 128) * (2 * DFF / 256) + (DFF / 128) * (D / 256), NQ_MOE = NEXP * ((D / 128) * (2 * MFF / 256) + (MFF / 128) * (D / 256));
__device__ __forceinline__ void p0_convert_tiles(LAS unsigned char* lds, const Wts& w, int vcu, int G) {
    constexpr int NT = NT_FFN;
    const int tid = threadIdx.x, lane = tid & 63, wave = __builtin_amdgcn_readfirstlane(tid >> 6);
    __syncthreads();
    int t = vcu; if (t >= NT) return;
    TileDesc p = tile_decode(w, t), q = p; f32x4 a[16], b[16];
    tile_load(p, wave, lane, a);
    for (;;) {
        t += G; const bool hq = t < NT;
        if (hq) { q = tile_decode(w, t); tile_load(q, wave, lane, b); }
        tile_to_lds(p, lds, wave, lane, a); __syncthreads(); tile_store(p, lds, tid);
        if (!hq) break;
        t += G; const bool hp = t < NT;
        if (hp) { p = tile_decode(w, t); tile_load(p, wave, lane, a); }
        tile_to_lds(q, lds + 32768, wave, lane, b); __syncthreads(); tile_store(q, lds + 32768, tid);
        if (!hp) break;
    }
    __syncthreads();
}

struct Args { const float* in[19]; float* out; unsigned char* ws; int ph_lo, ph_hi; };
constexpr int T_WAC = 2 * (DATT / 64) * (D / 256), T_WOUT = (D / 64) * (D / 256), T_WIN = (D / 128) * (DIN / 256);
constexpr int QA = T_WAC, QB = QA + T_WOUT, QC = QB + NT_FFN, QD = QC + T_WIN, QE = QD + T_WAC, QF = QE + T_WOUT, QG = QF + NEXP * (D / 128) * (2 * MFF / 256), NQ_ALL = QF + NQ_MOE;
constexpr int QMB_OFF = LDSCTL_OFF + 2560;
__device__ __forceinline__ TileDesc moe_tile_decode(const Args& args, int tq0) {
    constexpr int T_GU = (D / 128) * (2 * DFF / 256), T_DN = (DFF / 128) * (D / 256), T_MGU = (D / 128) * (2 * MFF / 256);
    if (tq0 < QB || (tq0 >= QD && tq0 < QF)) {
        const int l = tq0 >= QD ? 1 : 0, q = tq0 - (l ? QD : 0);
        TileDesc p; p.N = D; p.hstride = 128; p.mode = 0; p.scale = 1.0f;
        if (q < T_WAC) { const int which = q / (T_WAC / 2), rr = q % (T_WAC / 2), kt = rr % (DATT / 64), ct = rr / (DATT / 64);
            const GAS float* sb = (const GAS float*)(which ? args.in[11] : args.in[10]);
            p.src = (const float*)(sb + (size_t)l * DATT * D + (size_t)(64 * kt) * D + 256 * ct); p.pitch = DATT * 2;
            p.dst = (unsigned char*)((GAS unsigned char*)args.ws + WS_WAC + (((size_t)(2 * l + which) * D + 256 * ct) * DATT + 64 * kt) * 2); }
        else { const int rr = q - T_WAC, kt = rr % (D / 64), ct = rr / (D / 64);
            p.src = (const float*)((const GAS float*)args.in[12] + (size_t)l * D * D + (size_t)(64 * kt) * D + 256 * ct); p.pitch = D * 2;
            p.dst = (unsigned char*)((GAS unsigned char*)args.ws + WS_WOUT + (((size_t)l * D + 256 * ct) * D + 64 * kt) * 2); }
        return p;
    }
    if (tq0 >= QC && tq0 < QD) {
        const int rr = tq0 - QC, kt = rr % (D / 128), ct = rr / (D / 128);
        TileDesc p; p.N = DIN; p.pitch = D; p.hstride = 128; p.mode = 2; p.scale = W8I_SCALE; p.pg0 = 8 * ct;
        p.src = (const float*)((const GAS float*)args.in[5] + (size_t)D * DIN + (size_t)(128 * kt) * DIN + 256 * ct);
        p.dst = (unsigned char*)((GAS unsigned char*)args.ws + WS_WIN + (size_t)DIN * D + 128 * kt);
        return p;
    }
    const int tq = tq0 < QC ? tq0 - QB : tq0 - QF + NT_FFN;
    int r = tq, cls = 0;
    if (r >= T_GU) { r -= T_GU; cls = 1; if (r >= T_DN) { r -= T_DN; cls = 2; if (r >= NEXP * T_MGU) { r -= NEXP * T_MGU; cls = 3; } } }
    const bool isgu = (cls & 1) == 0; const int F = cls < 2 ? DFF : MFF;
    const int per = isgu ? (D / 128) * (2 * F / 256) : (F / 128) * (D / 256), nk = isgu ? D / 128 : F / 128;
    const int e = r / per, rr = r % per, kt = rr % nk, ct = rr / nk, col0 = 256 * ct, up = (isgu && col0 >= F) ? 1 : 0, j = (col0 - up * F) / 256;
    const size_t N = isgu ? 2 * F : D, pitch = isgu ? D : F, esz = isgu ? (size_t)D * 2 * F : (size_t)F * D;
    const GAS float* sb = (const GAS float*)(cls == 0 ? args.in[14] : cls == 1 ? args.in[15] : cls == 2 ? args.in[17] : args.in[18]);
    const size_t doff = cls == 0 ? WS_WGU : cls == 1 ? WS_WDN : cls == 2 ? WS_MGU : WS_MDN;
    GAS unsigned char* db = (GAS unsigned char*)args.ws + doff;
    TileDesc p;
    p.src = (const float*)(sb + (size_t)e * esz + (size_t)(128 * kt) * N + col0); p.N = (int)N; p.pitch = (int)pitch; p.hstride = isgu ? 256 : 128; p.mode = isgu ? 2 : 1;
    p.scale = isgu ? W8I_SCALE : (float)(1 << MDN8_LOG2);
    p.dst = (unsigned char*)(db + (size_t)e * esz + (isgu ? (size_t)(512 * j + 128 * up) * D : (size_t)(256 * ct) * F) + 128 * kt);
    return p;
}
__device__ __forceinline__ void convert_tiles(LAS unsigned char* lds, const Args& m, int tq, int n) {
    const int tid = threadIdx.x, lane = tid & 63, wave = __builtin_amdgcn_readfirstlane(tid >> 6);
    const TileDesc p = moe_tile_decode(m, tq); f32x4 a[16];
    tile_load(p, wave, lane, a);
    if (n == 2) {
        const TileDesc q = moe_tile_decode(m, tq + 1); f32x4 b2[16];
        tile_load(q, wave, lane, b2);
        tile_to_lds(p, lds, wave, lane, a); __syncthreads(); tile_store(p, lds, tid);
        tile_to_lds(q, lds + 32768, wave, lane, b2); __syncthreads(); tile_store(q, lds + 32768, tid); __syncthreads();
    } else { tile_to_lds(p, lds, wave, lane, a); __syncthreads(); tile_store(p, lds, tid); __syncthreads(); }
}
__device__ __forceinline__ void moe_tiles_rest(LAS unsigned char* lds, const Args& m, unsigned* qctr, unsigned limit) {
    volatile LAS unsigned* mb = (volatile LAS unsigned*)(lds + QMB_OFF);
    for (;;) {
        __syncthreads();
        if (threadIdx.x == 0) { unsigned t = 0xffffffffu;
            if (mb[3] == 0u && xb_ld(qctr) < limit) { t = xb_add(qctr, 2u); if (t >= (unsigned)NQ_ALL) { t = 0xffffffffu; mb[3] = 1u; } }
            mb[1] = t; }
        __syncthreads();
        const unsigned t = mb[1];
        if (t == 0xffffffffu) break;
        convert_tiles(lds, m, (int)t, (t + 1u < (unsigned)NQ_ALL) ? 2 : 1);
    }
    __syncthreads();
}
__device__ __forceinline__ void xcd_barrier_work(const XcdBarrier& b, LAS unsigned char* lds, const Args& m, unsigned* qctr) {
    volatile LAS unsigned* mb = (volatile LAS unsigned*)(lds + QMB_OFF);
    asm volatile("s_waitcnt vmcnt(0)" ::: "memory");
    __syncthreads();
    unsigned gen = 0u;
    if (threadIdx.x == 0) {
        unsigned* bar = b.bar;
        __builtin_amdgcn_s_waitcnt(0);
        unsigned nloc = b.st[0], nx = b.st[1];
        if (nloc == 0u) { xcd_barrier_complete(bar, b.x, nloc, nx); b.st[0] = nloc; b.st[1] = nx; }
        const unsigned old = xb_add(&bar[XB_XSUB(b.x)], 1u);
        gen = old / nloc;
        if (old + 1u == (gen + 1u) * nloc) {
            __builtin_amdgcn_fence(__ATOMIC_RELEASE, "agent");
            asm volatile("s_waitcnt vmcnt(0)" ::: "memory");
            const unsigned og = xb_add(&bar[XB_TOP], 1u);
            const unsigned tg = og / nx;
            if (og + 1u == (tg + 1u) * nx) xb_add(&bar[XB_TOPGEN], 1u);
            else XB_SPIN(xb_ld(&bar[XB_TOPGEN]) == tg, bar);
            __builtin_amdgcn_fence(__ATOMIC_ACQUIRE, "agent");
            xb_add(&bar[XB_XGEN(b.x)], 1u);
            asm volatile("s_waitcnt vmcnt(0)" ::: "memory");
            mb[0] = 1u;
        } else if (mb[3] != 0u) {
            XB_SPIN(xb_ld(&bar[XB_XGEN(b.x)]) == gen, bar);
            __builtin_amdgcn_fence(__ATOMIC_ACQUIRE, "agent");
            asm volatile("s_waitcnt vmcnt(0)" ::: "memory");
            mb[0] = 1u;
        } else mb[0] = 0u;
    }
    __syncthreads();
    if (mb[0] == 0u) {
        unsigned sp = 0u;
        for (;;) {
            if (threadIdx.x == 0) {
                unsigned* bar = b.bar;
                const unsigned xg = xb_ld(&bar[XB_XGEN(b.x)]);
                unsigned done = (xg != gen) ? 1u : 0u, t = 0xffffffffu;
                if (!done) {
                    if (mb[3] == 0u) { t = xb_add(qctr, 2u); if (t >= (unsigned)NQ_ALL) { t = 0xffffffffu; mb[3] = 1u; } else mb[2] = (t + 2u <= (unsigned)NQ_ALL) ? 2u : 1u; }
                    if (t == 0xffffffffu) { __builtin_amdgcn_s_sleep(1); if ((++sp & 255u) == 0u) { if (xb_ld(&bar[XB_TMO])) done = 1u; else if (sp > XB_SPIN_CAP) { atomicAdd(&bar[XB_TMO], 1u); done = 1u; } } }
                }
                if (done) { __builtin_amdgcn_fence(__ATOMIC_ACQUIRE, "agent"); asm volatile("s_waitcnt vmcnt(0)" ::: "memory"); }
                mb[0] = done; mb[1] = t;
            }
            __syncthreads();
            const unsigned done = mb[0], t = mb[1], cnt = mb[2];
            __syncthreads();
            if (done) break;
            if (t != 0xffffffffu) convert_tiles(lds, m, (int)t, (int)cnt);
        }
    }
    __syncthreads();
}

template <bool MOE, bool XBF16>
__device__ __forceinline__ void norm_phase(LAS unsigned char* lds, const void* X, const float* gain, const float* scale, const float* shift, unsigned char* H, float* SA,
                                           const float* Wr, int* TOKE, float* TOKW, int* CNT, int G) {
    LAS float* tabA = (LAS float*)lds; LAS float* tabB = (LAS float*)(lds + 8192); LAS float* WrT = (LAS float*)(lds + 16384); LAS int* cnt = (LAS int*)(lds + 16384 + 65536);
    const int tid = threadIdx.x, lane = tid & 63, wave = tid >> 6;
    if (MOE) { for (int i = tid; i < D * NEXP; i += 512) WrT[(i & 7) * D + (i >> 3)] = Wr[i]; }
    for (int rb = blockIdx.x; rb < T / 64; rb += G) {
        const int b = rb >> 6;
        for (int i = tid; i < D; i += 512) { tabA[i] = gain[i] * (1.0f + scale[(size_t)b * MODW + i]); tabB[i] = shift[(size_t)b * MODW + i]; }
        if (MOE && tid < 8) cnt[tid] = 0;
        __syncthreads();
        v2u rawb[8]; f32x4 rawf[8];
        { const size_t r0 = (size_t)rb * 64 + wave * 8;
#pragma unroll
          for (int j = 0; j < 8; ++j) { if (XBF16) rawb[j] = ((const GAS v2u*)((const bf16_t*)X + r0 * D))[lane + 64 * j]; else rawf[j] = ((const GAS f32x4*)((const float*)X + r0 * D))[lane + 64 * j]; } }
        for (int i = 0; i < 8; ++i) {
            const size_t row = (size_t)rb * 64 + wave * 8 + i;
            const size_t rnx = row + 1 < (size_t)T ? row + 1 : row;
            f32x4 v[8]; float ss = 0.f;
#pragma unroll
            for (int j = 0; j < 8; ++j) {
                if (XBF16) { const v2u w2 = rawb[j]; v[j] = (f32x4){bf_lo(w2.x), bf_hi(w2.x), bf_lo(w2.y), bf_hi(w2.y)}; rawb[j] = ((const GAS v2u*)((const bf16_t*)X + rnx * D))[lane + 64 * j]; }
                else { v[j] = rawf[j]; rawf[j] = ((const GAS f32x4*)((const float*)X + rnx * D))[lane + 64 * j]; }
                ss += (v[j][0] * v[j][0] + v[j][1] * v[j][1]) + (v[j][2] * v[j][2] + v[j][3] * v[j][3]); }
            const float rinv = 1.0f / sqrtf(wave_sum(ss) * (1.0f / D) + EPS);
            float amax = 0.f;
#pragma unroll
            for (int j = 0; j < 8; ++j) { const f32x4 a = *(const LAS f32x4*)(tabA + 4 * lane + 256 * j), bb = *(const LAS f32x4*)(tabB + 4 * lane + 256 * j);
                v[j] = v[j] * rinv * a + bb; amax = fmaxf(fmaxf(amax, fmaxf(fabsf(v[j][0]), fabsf(v[j][1]))), fmaxf(fabsf(v[j][2]), fabsf(v[j][3]))); }
#pragma unroll
            for (int o = 1; o < 64; o <<= 1) amax = fmaxf(amax, __shfl_xor(amax, o));
            const float qs = amax > 0.f ? 127.0f / amax : 0.f;
#pragma unroll
            for (int j = 0; j < 8; ++j) ((GAS unsigned*)(H + row * D))[lane + 64 * j] = pg8::pk4_i8(v[j][0] * qs, v[j][1] * qs, v[j][2] * qs, v[j][3] * qs);
            if (lane == 0) SA[row] = amax * (1.0f / 127.0f);
            if (MOE) {
                float lg[8];
#pragma unroll
                for (int e = 0; e < 8; ++e) { float s = 0.f;
#pragma unroll
                    for (int j = 0; j < 8; ++j) { const f32x4 w4 = *(const LAS f32x4*)(WrT + e * D + 4 * lane + 256 * j); s += (v[j][0] * w4[0] + v[j][1] * w4[1]) + (v[j][2] * w4[2] + v[j][3] * w4[3]); }
                    lg[e] = wave_sum(s); }
                int e0 = 0; float v0 = lg[0];
#pragma unroll
                for (int e = 1; e < 8; ++e) if (lg[e] > v0) { v0 = lg[e]; e0 = e; }
                int e1 = -1; float v1 = -3.0e38f;
#pragma unroll
                for (int e = 0; e < 8; ++e) if (e != e0 && lg[e] > v1) { v1 = lg[e]; e1 = e; }
                const float w0 = 1.0f / (1.0f + __expf(v1 - v0));
                if (lane == 0) { TOKE[2 * row] = e0; TOKE[2 * row + 1] = e1; TOKW[2 * row] = w0; TOKW[2 * row + 1] = 1.0f - w0; lds_add((cnt + e0), 1); lds_add((cnt + e1), 1); }
            }
        }
        __syncthreads();
        if (MOE && tid < 8) CNT[rb * 8 + tid] = cnt[tid];
        __syncthreads();
    }
}

__device__ __forceinline__ void moe_slots(LAS unsigned char* lds, const unsigned char* H, const float* SA, const int* TOKE, const int* CNT, int* SLOT, int* GT, unsigned char* XG, float* SAg, int G) {
    LAS int* tot = (LAS int*)lds; LAS int* pre = tot + 8; LAS int* basee = tot + 16; LAS int* padn = tot + 24; LAS int* pads = tot + 32; LAS int* eArr = tot + 64; LAS int* sArr = tot + 192;
    const int tid = threadIdx.x, lane = tid & 63, wave = tid >> 6;
    for (int rb = blockIdx.x; rb < T / 64; rb += G) {
        if (tid < 16) tot[tid] = 0;
        __syncthreads();
        { const int wq = tid >> 1, hf = tid & 1; const int4 c4 = *(const int4*)(CNT + wq * 8 + hf * 4); const bool lt = wq < rb;
          lds_add((tot + hf * 4 + 0), c4.x); lds_add((tot + hf * 4 + 1), c4.y); lds_add((tot + hf * 4 + 2), c4.z); lds_add((tot + hf * 4 + 3), c4.w);
          if (lt) { lds_add((pre + hf * 4 + 0), c4.x); lds_add((pre + hf * 4 + 1), c4.y); lds_add((pre + hf * 4 + 2), c4.z); lds_add((pre + hf * 4 + 3), c4.w); } }
        __syncthreads();
        if (tid == 0) { int rt = 0;
            for (int e = 0; e < 8; ++e) { const int n = (tot[e] + 255) >> 8; basee[e] = rt * 256 + pre[e]; pads[e] = rt * 256 + tot[e]; padn[e] = n * 256 - tot[e];
                if (rb == 0) { GT[e] = rt; GT[8 + e] = n; } rt += n; } }
        if (tid < 128) eArr[tid] = TOKE[(size_t)rb * 128 + tid];
        __syncthreads();
        if (tid < 128) { const int e = eArr[tid]; int rank = 0; for (int p = 0; p < tid; ++p) rank += (eArr[p] == e) ? 1 : 0;
            const int slot = basee[e] + rank; sArr[tid] = slot; SLOT[(size_t)rb * 128 + tid] = slot; SAg[slot] = SA[(size_t)rb * 64 + (tid >> 1)]; }
        __syncthreads();
        for (int tk = wave * 8; tk < wave * 8 + 8; tk += 4) {
            v4u a[4][2];
#pragma unroll
            for (int q = 0; q < 4; ++q) { const GAS v4u* s = (const GAS v4u*)(H + ((size_t)rb * 64 + tk + q) * D) + lane; a[q][0] = s[0]; a[q][1] = s[64]; }
#pragma unroll
            for (int q = 0; q < 4; ++q) {
                GAS v4u* d0 = (GAS v4u*)(XG + (size_t)sArr[2 * (tk + q)] * D) + lane; GAS v4u* d1 = (GAS v4u*)(XG + (size_t)sArr[2 * (tk + q) + 1] * D) + lane;
                d0[0] = a[q][0]; d0[64] = a[q][1]; d1[0] = a[q][0]; d1[64] = a[q][1]; }
        }
        if (rb < padn[wave]) { GAS v4u* d = (GAS v4u*)(XG + (size_t)(pads[wave] + rb) * D) + lane; const v4u z = {0u, 0u, 0u, 0u}; d[0] = z; d[64] = z; if (lane == 0) SAg[pads[wave] + rb] = 0.f; }
        __syncthreads();
    }
}
constexpr int SLOT_SPLIT = 128 * 256; constexpr size_t YP_STRIDE = (size_t)8 * 256 * D;
__device__ __forceinline__ f32x4 load_y4(const bf16_t* Y, const bf16_t* YP, int slot, int idx) {
    if (slot < SLOT_SPLIT) { const v2u a = ((const GAS v2u*)(Y + (size_t)slot * D))[idx]; return (f32x4){bf_lo(a.x), bf_hi(a.x), bf_lo(a.y), bf_hi(a.y)}; }
    f32x4 r = {0.f, 0.f, 0.f, 0.f};
#pragma unroll
    for (int p = 0; p < 4; ++p) { const v2u a = ((const GAS v2u*)(YP + p * YP_STRIDE + (size_t)(slot - SLOT_SPLIT) * D))[idx]; r += (f32x4){bf_lo(a.x), bf_hi(a.x), bf_lo(a.y), bf_hi(a.y)}; }
    return r;
}
__device__ __forceinline__ void moe_combine(const bf16_t* X1, const bf16_t* Y, const bf16_t* YP, const int* SLOT, const float* TOKW, const float* gate, float* out, int vcu, int G) {
    const int lane = threadIdx.x & 63, wave = threadIdx.x >> 6;
    for (int row = vcu * 8 + wave; row < T; row += G * 8) {
        const int s0 = SLOT[2 * row], s1 = SLOT[2 * row + 1]; const float w0 = TOKW[2 * row], w1 = TOKW[2 * row + 1];
        const GAS v2u* x = (const GAS v2u*)(X1 + (size_t)row * D) + lane;
        const GAS f32x4* g = (const GAS f32x4*)(gate + (size_t)(row >> 12) * MODW) + lane; GAS f32x4* o = (GAS f32x4*)(out + (size_t)row * D) + lane;
        if (s0 < SLOT_SPLIT && s1 < SLOT_SPLIT) {
            const GAS v2u* y0 = (const GAS v2u*)(Y + (size_t)s0 * D) + lane; const GAS v2u* y1 = (const GAS v2u*)(Y + (size_t)s1 * D) + lane;
#pragma unroll
            for (int j = 0; j < 8; ++j) { const v2u a = y0[64 * j], b = y1[64 * j];
                const f32x4 ya = {bf_lo(a.x), bf_hi(a.x), bf_lo(a.y), bf_hi(a.y)}, yb = {bf_lo(b.x), bf_hi(b.x), bf_lo(b.y), bf_hi(b.y)};
                const v2u xw = x[64 * j]; const f32x4 xv = {bf_lo(xw.x), bf_hi(xw.x), bf_lo(xw.y), bf_hi(xw.y)};
                o[64 * j] = xv + g[64 * j] * (ya * w0 + yb * w1); }
        } else {
            const bool sp0 = s0 >= SLOT_SPLIT, sp1 = s1 >= SLOT_SPLIT;
            const GAS v2u* p0 = (const GAS v2u*)(sp0 ? YP + (size_t)(s0 - SLOT_SPLIT) * D : Y + (size_t)s0 * D) + lane; const size_t st0 = sp0 ? YP_STRIDE / 4 : 0;
            const GAS v2u* p1 = (const GAS v2u*)(sp1 ? YP + (size_t)(s1 - SLOT_SPLIT) * D : Y + (size_t)s1 * D) + lane; const size_t st1 = sp1 ? YP_STRIDE / 4 : 0;
            const float m0 = sp0 ? w0 : 0.f, m1 = sp1 ? w1 : 0.f;
#pragma unroll
            for (int j = 0; j < 8; ++j) { f32x4 acc4 = {0.f, 0.f, 0.f, 0.f};
#pragma unroll
                for (int p = 0; p < 4; ++p) { const v2u a = p0[64 * j + p * st0], b = p1[64 * j + p * st1]; const float wa = p ? m0 : w0, wb = p ? m1 : w1;
                    acc4 += (f32x4){bf_lo(a.x), bf_hi(a.x), bf_lo(a.y), bf_hi(a.y)} * wa + (f32x4){bf_lo(b.x), bf_hi(b.x), bf_lo(b.y), bf_hi(b.y)} * wb; }
                const v2u xw = x[64 * j]; const f32x4 xv = {bf_lo(xw.x), bf_hi(xw.x), bf_lo(xw.y), bf_hi(xw.y)};
                o[64 * j] = xv + g[64 * j] * acc4; }
        }
    }
}

__device__ __forceinline__ void attn_conv_phase(LAS unsigned char* lds, const bf16_t* Q, const bf16_t* Kb, const bf16_t* Vb, const bf16_t* BC, const bf16_t* U, const float* convw, const float* sinks,
                                                bf16_t* AC, int G) {
    constexpr int KSTR = 144, VSTR = 560;
    LAS unsigned char* Ks = lds; LAS unsigned char* Vt = lds + 256 * KSTR;
    const int tid = threadIdx.x, lane = tid & 63, wave = tid >> 6, fr = lane & 15, fq = lane >> 4;
    for (int unit = blockIdx.x; unit < NBATCH * 32 * 4; unit += G) {
        const int kvh = unit & 3, nb = (unit >> 2) & 31, b = unit >> 7;
        const long tok0 = (long)b * SEQ + nb * 128 - 128;
        __syncthreads();
#pragma unroll
        for (int i = 0; i < 4; ++i) { const int task = tid + 512 * i, krel = task >> 3, ch = task & 7; v4u val = {0u, 0u, 0u, 0u};
            if (nb > 0 || krel >= 128) val = *(const GAS v4u*)(Kb + (size_t)(tok0 + krel) * DKV + kvh * 64 + ch * 8);
            *(LAS v4u*)(Ks + krel * KSTR + ch * 16) = val; }
#pragma unroll
        for (int i = 0; i < 4; ++i) { const int task = tid + 512 * i, krel = task & 255, ch = task >> 8; v4u val = {0u, 0u, 0u, 0u};
            if (nb > 0 || krel >= 128) val = *(const GAS v4u*)(Vb + (size_t)(tok0 + krel) * DKV + kvh * 64 + ch * 8);
            LAS unsigned short* vp = (LAS unsigned short*)(Vt + (ch * 8) * VSTR + krel * 2);
            vp[0 * (VSTR / 2)] = (unsigned short)(val.x & 0xffffu); vp[1 * (VSTR / 2)] = (unsigned short)(val.x >> 16); vp[2 * (VSTR / 2)] = (unsigned short)(val.y & 0xffffu); vp[3 * (VSTR / 2)] = (unsigned short)(val.y >> 16);
            vp[4 * (VSTR / 2)] = (unsigned short)(val.z & 0xffffu); vp[5 * (VSTR / 2)] = (unsigned short)(val.z >> 16); vp[6 * (VSTR / 2)] = (unsigned short)(val.w & 0xffffu); vp[7 * (VSTR / 2)] = (unsigned short)(val.w >> 16); }
        { const int d = tid >> 3, c = tid & 7; *(LAS unsigned*)(Vt + d * VSTR + 512 + c * 4) = 0u; }
        const int hq = kvh * 4 + (wave >> 1), half = wave & 1;
        const bf16_t* qbase = Q + ((size_t)b * SEQ + nb * 128 + half * 64 + fr) * DATT + hq * 64 + fq * 8;
        bf16x8 qn0 = *(const GAS bf16x8*)qbase, qn1 = *(const GAS bf16x8*)(qbase + 32);
        __syncthreads();
        const float slope2 = __builtin_amdgcn_exp2f(-0.5f * (float)(hq + 1)) * LOG2E, sink2 = sinks[hq] * LOG2E;
        for (int st = 0; st < 4; ++st) {
            const int i0 = half * 64 + st * 16, t0 = i0 >> 4;
            const size_t qrow = (size_t)b * SEQ + nb * 128 + i0 + fr;
            const bf16x8 qf0 = qn0, qf1 = qn1;
            if (st < 3) { qn0 = *(const GAS bf16x8*)(qbase + (size_t)(st + 1) * 16 * DATT); qn1 = *(const GAS bf16x8*)(qbase + (size_t)(st + 1) * 16 * DATT + 32); }
            f32x4 S[9];
#pragma unroll
            for (int tt = 0; tt < 9; ++tt) { const LAS unsigned char* kp = Ks + (16 * (t0 + tt) + fr) * KSTR + fq * 16;
                const bf16x8 k0 = *(const LAS bf16x8*)kp, k1 = *(const LAS bf16x8*)(kp + 64);
                f32x4 s = {0.f, 0.f, 0.f, 0.f};
                s = __builtin_amdgcn_mfma_f32_16x16x32_bf16(k0, qf0, s, 0, 0, 0); s = __builtin_amdgcn_mfma_f32_16x16x32_bf16(k1, qf1, s, 0, 0, 0); S[tt] = s; }
            const int df = fr - 4 * fq; float mx = sink2;
#pragma unroll
            for (int tt = 0; tt < 9; ++tt)
#pragma unroll
                for (int j = 0; j < 4; ++j) { const int dist = 128 - 16 * tt + df - j; bool valid = true;
                    if (tt == 0) valid = (df - j) < 0; if (tt == 8) valid = (df - j) >= 0; if (nb == 0 && t0 + tt < 8) valid = false;
                    const float lg = valid ? (S[tt][j] - slope2 * (float)dist) : -__builtin_inff(); S[tt][j] = lg; mx = fmaxf(mx, lg); }
            mx = fmaxf(mx, __shfl_xor(mx, 16)); mx = fmaxf(mx, __shfl_xor(mx, 32));
            float lsum = 0.f;
#pragma unroll
            for (int tt = 0; tt < 9; ++tt)
#pragma unroll
                for (int j = 0; j < 4; ++j) { const float p = __builtin_amdgcn_exp2f(S[tt][j] - mx); S[tt][j] = p; lsum += p; }
            lsum += __shfl_xor(lsum, 16); lsum += __shfl_xor(lsum, 32); lsum += __builtin_amdgcn_exp2f(sink2 - mx);
            const float inv = 1.0f / lsum;
            f32x4 O[4];
#pragma unroll
            for (int dt = 0; dt < 4; ++dt) O[dt] = (f32x4){0.f, 0.f, 0.f, 0.f};
#pragma unroll
            for (int uu = 0; uu < 5; ++uu) {
                v4u pw; pw.x = pg8::cvt_pk_bf16(S[2 * uu][0], S[2 * uu][1]); pw.y = pg8::cvt_pk_bf16(S[2 * uu][2], S[2 * uu][3]);
                if (uu < 4) { pw.z = pg8::cvt_pk_bf16(S[2 * uu + 1 > 8 ? 8 : 2 * uu + 1][0], S[2 * uu + 1 > 8 ? 8 : 2 * uu + 1][1]); pw.w = pg8::cvt_pk_bf16(S[2 * uu + 1 > 8 ? 8 : 2 * uu + 1][2], S[2 * uu + 1 > 8 ? 8 : 2 * uu + 1][3]); }
                else { pw.z = 0u; pw.w = 0u; }
                const bf16x8 pb = __builtin_bit_cast(bf16x8, pw);
#pragma unroll
                for (int dt = 0; dt < 4; ++dt) { const LAS unsigned char* vp = Vt + (16 * dt + fr) * VSTR + (16 * (t0 + 2 * uu) + 4 * fq) * 2;
                    const s16x4 lo = *(const LAS s16x4*)vp, hi = *(const LAS s16x4*)(vp + 32);
                    const bf16x8 va = __builtin_shufflevector(lo, hi, 0, 1, 2, 3, 4, 5, 6, 7);
                    O[dt] = __builtin_amdgcn_mfma_f32_16x16x32_bf16(va, pb, O[dt], 0, 0, 0); }
            }
            bf16_t* op = AC + qrow * DATT + hq * 64 + 4 * fq;
#pragma unroll
            for (int dt = 0; dt < 4; ++dt) { v2u o; o.x = pg8::cvt_pk_bf16(O[dt][0] * inv, O[dt][1] * inv); o.y = pg8::cvt_pk_bf16(O[dt][2] * inv, O[dt][3] * inv); *(GAS v2u*)(op + 16 * dt) = o; }
        }
    }
    bf16_t* CO = AC + (size_t)T * DATT;
    for (int rb = blockIdx.x; rb < T / 64; rb += G) {
#pragma unroll 4
        for (int i = 0; i < 16; ++i) { const int task = tid + 512 * i; const size_t row = (size_t)rb * 64 + (task >> 7); const int ch0 = (task & 127) * 8, tseq = (int)(row & (SEQ - 1));
            const v4u z = {0u, 0u, 0u, 0u};
            const v4u u0 = *(const GAS v4u*)(U + row * DCONV + ch0), u1 = tseq >= 1 ? *(const GAS v4u*)(U + (row - 1) * DCONV + ch0) : z, u2 = tseq >= 2 ? *(const GAS v4u*)(U + (row - 2) * DCONV + ch0) : z;
            const v4u bc = *(const GAS v4u*)(BC + row * DCONV + ch0);
            f32x4 a0, b0, a1, b1, a2, b2, ab, bb; pg8::unpack8(u0, a0, b0); pg8::unpack8(u1, a1, b1); pg8::unpack8(u2, a2, b2); pg8::unpack8(bc, ab, bb);
            const f32x4 w0a = *(const f32x4*)(convw + ch0), w0b = *(const f32x4*)(convw + ch0 + 4), w1a = *(const f32x4*)(convw + DCONV + ch0), w1b = *(const f32x4*)(convw + DCONV + ch0 + 4),
                        w2a = *(const f32x4*)(convw + 2 * DCONV + ch0), w2b = *(const f32x4*)(convw + 2 * DCONV + ch0 + 4);
            const f32x4 ya = ab * (w0a * a2 + w1a * a1 + w2a * a0), yb = bb * (w0b * b2 + w1b * b1 + w2b * b0);
            *(GAS v4u*)(CO + row * DCONV + ch0) = pg8::pack8(ya, yb); }
    }
}

constexpr int N_PHASES = 19;
#define RUN(k) (lo <= (k) && (k) < hi)
#define SEAM(k) do { if (RUN(k) && RUN((k) + 1)) { XcdBarrier b2_ = bar; unsigned char* ws_ = WSB(); b2_.bar = (unsigned*)(ws_ + WS_CTL) + CW_BAR; xcd_barrier_work(b2_, lds, args, (unsigned*)(ws_ + WS_CTL + 49152)); } } while (0)
#define WSB() ({ GAS unsigned char* _w = (GAS unsigned char*)args.ws; asm volatile("" : "+s"(_w)); (unsigned char*)_w; })
#define INP(i) ((const float*)(const GAS float*)args.in[i])
#define WP(type, off) ((type*)(ws + (off)))
template <int l>
__device__ __forceinline__ void layer_phases(const Args& args, LAS unsigned char* lds, const XcdBarrier& bar, const int lo, const int hi, const int G, const int bx, const int vcu) {
        const int pb = l * 8;
        if (RUN(pb + 1)) { unsigned char* ws = WSB(); const float* modl = WP(float, WS_MOD) + (size_t)l * NBATCH * MODW;
            if (l == 0) norm_phase<false, false>(lds, INP(0), INP(4) + l * D, modl + 1 * D, modl + 0 * D, WP(unsigned char, WS_H), WP(float, WS_MOE + 458752), nullptr, nullptr, nullptr, nullptr, G);
            else norm_phase<false, true>(lds, WP(bf16_t, WS_X2), INP(4) + l * D, modl + 1 * D, modl + 0 * D, WP(unsigned char, WS_H), WP(float, WS_MOE + 458752), nullptr, nullptr, nullptr, nullptr, G); }
        if (l == 1 && RUN(pb + 1)) { unsigned char* ws = WSB(); moe_tiles_rest(lds, args, WP(unsigned, WS_CTL + 49152), (unsigned)QD); }
        SEAM(pb + 1);
        if (RUN(pb + 2)) { unsigned char* ws = WSB();
            pg8::Gemm g{WP(bf16_t, WS_H), (const bf16_t*)(WP(unsigned char, WS_WIN) + (size_t)l * DIN * D), T, DIN, D / 2}; pg8::StaticOrder S; S.init(T, DIN, G, bx);
            pg8::EpiWin E{WP(bf16_t, WS_Q), WP(bf16_t, WS_K), WP(bf16_t, WS_V), WP(bf16_t, WS_BC), WP(bf16_t, WS_U), WP(bf16_t, WS_R), WP(bf16_t, WS_GC), INP(6) + l * 64, INP(7) + l * 64, WP(float, WS_MOE + 458752), 1.0f / W8I_SCALE};
            pg8::gemm_phase<pg8::EpiWin, pg8::StaticOrder, true, true, 2>(lds, g, S, E);
        }
        SEAM(pb + 2);
        if (RUN(pb + 3)) { unsigned char* ws = WSB();
            attn_conv_phase(lds, WP(bf16_t, WS_Q), WP(bf16_t, WS_K), WP(bf16_t, WS_V), WP(bf16_t, WS_BC), WP(bf16_t, WS_U), INP(9) + (size_t)l * 3 * DCONV, INP(8) + l * 16, WP(bf16_t, WS_AC), G); }
        if (RUN(pb + 3)) { unsigned char* ws = WSB(); moe_tiles_rest(lds, args, WP(unsigned, WS_CTL + 49152), (unsigned)(l == 0 ? QA : QE)); }
        SEAM(pb + 3);
        if (RUN(pb + 4)) { unsigned char* ws = WSB();
            pg8::Gemm g{WP(bf16_t, WS_AC), WP(bf16_t, WS_WAC) + (size_t)l * 2 * D * DATT, 2 * T, 2 * D, DATT}; pg8::MergeOrder S; S.init(G, bx);
            pg8::EpiMerge E{WP(bf16_t, WS_R), WP(bf16_t, WS_GC), WP(bf16_t, WS_MG)};
            pg8::gemm_phase<pg8::EpiMerge, pg8::MergeOrder, true, true>(lds, g, S, E);
        }
        if (RUN(pb + 4)) { unsigned char* ws = WSB(); moe_tiles_rest(lds, args, WP(unsigned, WS_CTL + 49152), (unsigned)(l == 0 ? QB : QF)); }
        SEAM(pb + 4);
        if (RUN(pb + 5)) { unsigned char* ws = WSB(); const float* modl = WP(float, WS_MOD) + (size_t)l * NBATCH * MODW;
            pg8::Gemm g{WP(bf16_t, WS_MG), WP(bf16_t, WS_WOUT) + (size_t)l * D * D, T, D, D}; pg8::StaticOrder S; S.init(T, D, G, bx);
            if (l == 0) { pg8::EpiResid<false> E{INP(0), WP(bf16_t, WS_X1), modl + 2 * D}; pg8::gemm_phase<pg8::EpiResid<false>, pg8::StaticOrder, true, true>(lds, g, S, E); }
            else { pg8::EpiResid<true> E{WP(bf16_t, WS_X2), WP(bf16_t, WS_X1), modl + 2 * D}; pg8::gemm_phase<pg8::EpiResid<true>, pg8::StaticOrder, true, true>(lds, g, S, E); }
        }
        SEAM(pb + 5);
        if (RUN(pb + 6)) { unsigned char* ws = WSB(); const float* modl = WP(float, WS_MOD) + (size_t)l * NBATCH * MODW;
            if (l == 0) norm_phase<false, true>(lds, WP(bf16_t, WS_X1), INP(13) + l * D, modl + 4 * D, modl + 3 * D, WP(unsigned char, WS_H), WP(float, WS_MOE + 458752), nullptr, nullptr, nullptr, nullptr, G);
            else        norm_phase<true, true>(lds, WP(bf16_t, WS_X1), INP(13) + l * D, modl + 4 * D, modl + 3 * D, WP(unsigned char, WS_H), WP(float, WS_MOE + 458752), INP(16), WP(int, WS_MOE + 65536), WP(float, WS_MOE + 196608), WP(int, WS_MOE), G);
        }
        if (l == 0 && RUN(pb + 6)) { unsigned char* ws = WSB(); moe_tiles_rest(lds, args, WP(unsigned, WS_CTL + 49152), (unsigned)QC); }
        SEAM(pb + 6);
        if constexpr (l == 0) {
            if (RUN(7)) { unsigned char* ws = WSB();
                pg8::Gemm g{WP(bf16_t, WS_H), WP(bf16_t, WS_WGU), T, 2 * DFF, D / 2}; pg8::StaticOrder S; S.init(T, 2 * DFF, G, bx);
                pg8::EpiSwiglu8 E{WP(unsigned char, WS_ACT), DFF, 2 * DFF / 256, WP(float, WS_MOE + 458752), 1.0f / W8I_SCALE};
                pg8::gemm_phase<pg8::EpiSwiglu8, pg8::StaticOrder, true, true, 2>(lds, g, S, E);
            }
            SEAM(7);
            if (RUN(8)) { unsigned char* ws = WSB(); const float* modl = WP(float, WS_MOD);
                pg8::Gemm g{WP(bf16_t, WS_ACT), WP(bf16_t, WS_WDN), T, D, DFF / 2, ((127 - 2) << 8) | (127 - MDN8_LOG2)}; pg8::StaticOrder S; S.init(T, D, G, bx);
                pg8::EpiResid<true> E{WP(bf16_t, WS_X1), WP(bf16_t, WS_X2), modl + 5 * D};
                pg8::gemm_phase<pg8::EpiResid<true>, pg8::StaticOrder, true, true, 1>(lds, g, S, E);
            }
            SEAM(8);
        } else {
            if (RUN(15)) { unsigned char* ws = WSB(); moe_slots(lds, WP(unsigned char, WS_H), WP(float, WS_MOE + 458752), WP(int, WS_MOE + 65536), WP(int, WS_MOE), WP(int, WS_MOE + 327680), WP(int, WS_MOE + 16384), WP(unsigned char, WS_XG), WP(float, WS_MOE + 524288), G); }
            if (RUN(15)) { unsigned char* ws = WSB(); moe_tiles_rest(lds, args, WP(unsigned, WS_CTL + 49152), (unsigned)QG); }
            SEAM(15);
            if (RUN(16)) { unsigned char* ws = WSB();
                pg8::Gemm g{WP(bf16_t, WS_XG), WP(bf16_t, WS_MGU), NSLOT, NEXP * 2 * MFF, D / 2}; pg8::GroupedOrder S; S.init((LAS int*)(lds + LDSCTL_OFF + 1024), WP(int, WS_MOE + 16384), 2 * MFF / 256, G, bx);
                pg8::EpiSwiglu8 E{WP(unsigned char, WS_ACT), MFF, 2 * MFF / 256, WP(float, WS_MOE + 524288), 1.0f / W8I_SCALE};
                pg8::gemm_phase<pg8::EpiSwiglu8, pg8::GroupedOrder, true, true, 2>(lds, g, S, E);
                moe_tiles_rest(lds, args, WP(unsigned, WS_CTL + 49152), (unsigned)NQ_ALL);
            }
            SEAM(16);
            if (RUN(17)) { unsigned char* ws = WSB();
                pg8::GroupedOrder S0; S0.init((LAS int*)(lds + LDSCTL_OFF + 1024), WP(int, WS_MOE + 16384), D / 256, G, bx);
                const int ntiles = S0.total / (D / 256);
                { pg8::Gemm g{WP(bf16_t, WS_ACT), WP(bf16_t, WS_MDN), NSLOT, NEXP * D, MFF / 2, ((127 - 2) << 8) | (127 - MDN8_LOG2)};
                  pg8::DownMainOrder S; S.init((LAS int*)(lds + LDSCTL_OFF + 1024), G, bx);
                  pg8::EpiY E{WP(bf16_t, WS_Y), 0};
                  pg8::gemm_phase<pg8::EpiY, pg8::DownMainOrder, true, true, 1>(lds, g, S, E); }
                { const size_t koff = (size_t)(bx & 3) * (MFF / 4);
                  pg8::Gemm g{(const bf16_t*)(WP(unsigned char, WS_ACT) + koff), (const bf16_t*)(WP(unsigned char, WS_MDN) + koff), NSLOT, NEXP * D, MFF / 2, ((127 - 2) << 8) | (127 - MDN8_LOG2), MFF / 8};
                  pg8::DownSpillOrder S; S.init((LAS int*)(lds + LDSCTL_OFF + 1024), bx, ntiles);
                  pg8::EpiY E{WP(bf16_t, WS_Y + 136 * MiB) + (size_t)(bx & 3) * YP_STRIDE, 128};
                  pg8::gemm_phase<pg8::EpiY, pg8::DownSpillOrder, true, true, 1>(lds, g, S, E); }
            }
            SEAM(17);
            if (RUN(18)) { unsigned char* ws = WSB(); const float* modl = WP(float, WS_MOD) + (size_t)NBATCH * MODW;
                moe_combine(WP(bf16_t, WS_X1), WP(bf16_t, WS_Y), WP(bf16_t, WS_Y + 136 * MiB), WP(int, WS_MOE + 327680), WP(float, WS_MOE + 196608), modl + 5 * D, args.out, vcu, G); }
        }
}
__global__ void __launch_bounds__(512, 2) mk_fwd(Args args) {
    extern __shared__ __attribute__((aligned(16))) unsigned char lds_raw[];
    LAS unsigned char* lds = (LAS unsigned char*)lds_raw;
    const int tid = threadIdx.x;
    const int G = gridDim.x; const int bx = blockIdx.x; const int vcu = (G % 8 == 0) ? (bx % 8) * (G / 8) + bx / 8 : bx;
    unsigned* ctl = (unsigned*)(GAS unsigned*)(args.ws + WS_CTL);
    for (int u = tid; u < (LDS_BYTES - LDSCTL_OFF) / 4; u += 512) ((LAS unsigned*)(lds + LDSCTL_OFF))[u] = 0u;
    __syncthreads();
    XcdBarrier bar = xcd_barrier_post(ctl + CW_BAR, (volatile LAS unsigned*)(lds + MISC_OFF) + 8);
    const int lo = args.ph_lo, hi = args.ph_hi;


    if (RUN(0)) {
        unsigned char* ws = WSB();
        p0_mod(lds, INP(1), INP(2), INP(3), WP(float, WS_MOD), G);
        Wts w; w.w_in = INP(5); w.w_ab = INP(10); w.w_cb = INP(11); w.w_out = INP(12); w.ffn_gu = INP(14); w.ffn_dn = INP(15); w.moe_gu = INP(17); w.moe_dn = INP(18);
        w.WIN = WP(unsigned char, WS_WIN); w.WAC = WP(bf16_t, WS_WAC); w.WOUT = WP(bf16_t, WS_WOUT); w.WGU = WP(unsigned char, WS_WGU); w.WDN = WP(unsigned char, WS_WDN); w.MGU = WP(unsigned char, WS_MGU); w.MDN = WP(unsigned char, WS_MDN);
        p0_convert(lds, w, vcu, G);
    }
    SEAM(0);
    layer_phases<0>(args, lds, bar, lo, hi, G, bx, vcu);
    layer_phases<1>(args, lds, bar, lo, hi, G, bx, vcu);
}

extern "C" void kernel_launch(void* const* d_in, const int* in_sizes, int n_in, void* d_out, int out_size, void* d_ws, size_t ws_size, hipStream_t stream) {
    static int grid = 0;
    if (grid == 0) {
        if (n_in != 19 || in_sizes[0] != T * D || out_size != T * D || ws_size < WS_END) { fprintf(stderr, "kernel_launch: unexpected problem (n_in %d, x %d, out %d, ws %zu < %zu); nothing launched\n", n_in, n_in > 0 ? in_sizes[0] : -1, out_size, ws_size, (size_t)WS_END); grid = -1; return; }
        int dev = 0, cus = 0, per_cu = 0;
        if (hipGetDevice(&dev) != hipSuccess || hipDeviceGetAttribute(&cus, hipDeviceAttributeMultiprocessorCount, dev) != hipSuccess) { fprintf(stderr, "kernel_launch: device query failed\n"); grid = -1; return; }
        if (hipFuncSetAttribute((const void*)mk_fwd, hipFuncAttributeMaxDynamicSharedMemorySize, LDS_BYTES) != hipSuccess) { fprintf(stderr, "kernel_launch: hipFuncSetAttribute failed\n"); grid = -1; return; }
        if (hipOccupancyMaxActiveBlocksPerMultiprocessor(&per_cu, (const void*)mk_fwd, 512, LDS_BYTES) != hipSuccess || per_cu < 1) fprintf(stderr, "kernel_launch: note: occupancy query reports %d workgroups per CU\n", per_cu);
        (void)hipGetLastError();
        grid = cus;
    }
    if (grid < 0) return;
    if (hipMemsetAsync((char*)d_ws + WS_CTL, 0, CTL_ZERO_BYTES, stream) != hipSuccess) { fprintf(stderr, "kernel_launch: memset failed\n"); return; }
    Args a{};
    for (int i = 0; i < 19; ++i) a.in[i] = (const float*)d_in[i];
    a.out = (float*)d_out; a.ws = (unsigned char*)d_ws;
#if MK_N_LAUNCHES == 1
    a.ph_lo = 0; a.ph_hi = N_PHASES;
    hipLaunchKernelGGL(mk_fwd, dim3(grid), dim3(512), LDS_BYTES, stream, a);
#else
    for (int p = 0; p < N_PHASES; ++p) { a.ph_lo = p; a.ph_hi = p + 1; const int reps = ((MK_PROBE_MASK >> p) & 1) ? 2 : 1;
        for (int r = 0; r < reps; ++r) hipLaunchKernelGGL(mk_fwd, dim3(grid), dim3(512), LDS_BYTES, stream, a); }
#endif
    const hipError_t le = hipPeekAtLastError();
    if (le != hipSuccess) fprintf(stderr, "kernel_launch: launch failed: %s\n", hipGetErrorName(le));
}
```
